# Optimizing an MI355X kernel written in HIP

```python
import math
import jax, jax.numpy as jnp
from jax import lax
import numpy as np

D_MODEL = 1024
BATCH = 8
SEQ = 4096
DEPTH = 4

GRID_W = 64
CTX_LEN = 256
BR_W = 512
D_A = BR_W
N_A = 64
H_A = D_A // N_A
R_DECAY = 64
R_ICLR = 64
GN_EPS = 64e-5
D_B = BR_W
CONV_K = 3
H_C = 4
DH_C = 64
DV_C = 2 * DH_C
D_QC = H_C * 2 * DH_C
D_C = H_C * DV_C
Q_BLOCK = 128
ROPE_BASE = 10000.0
N_BRANCH = 3
RMS_EPS = 1e-6
IN_WIDTHS = (D_A, D_A, D_A, R_DECAY, R_DECAY, R_ICLR, R_ICLR, D_A,
             D_B, D_B, D_B, D_B,
             D_QC, D_QC, D_C, D_C,
             N_BRANCH * D_MODEL)
N_IN = 4 * D_A + 2 * R_DECAY + 2 * R_ICLR + 4 * D_B + 2 * D_QC + 2 * D_C + N_BRANCH * D_MODEL

kernel_name = "hybrid_rwkv7_shortconv_diffattn_prefix_dit"


def rms_norm(x, g):
    xf = x.astype(jnp.float32)
    y = xf * lax.rsqrt(jnp.mean(xf * xf, axis=-1, keepdims=True) + RMS_EPS)
    return (y * g.astype(jnp.float32)).astype(x.dtype)


def heads(t, n):
    return t.reshape(t.shape[:-1] + (n, t.shape[-1] // n))


def split_columns(p):
    offsets = [int(o) for o in np.cumsum(IN_WIDTHS)[:-1]]
    return jnp.split(p, offsets, axis=-1)


def adaln_modulate(x, g, cond, w_mod, b_mod):
    mod = jax.nn.silu(cond) @ w_mod + b_mod
    shift, scale, gate = jnp.split(mod, 3, axis=-1)
    return rms_norm(x, g) * (1 + scale) + shift, gate


def axial_rope_angles(n_tokens):
    rows = n_tokens // GRID_W
    row = jnp.repeat(jnp.arange(rows), GRID_W).astype(jnp.float32)
    col = jnp.tile(jnp.arange(GRID_W), rows).astype(jnp.float32)
    n_freq = DH_C // 4
    inv_freq = ROPE_BASE ** (-jnp.arange(n_freq, dtype=jnp.float32) / n_freq)
    return jnp.concatenate([row[:, None] * inv_freq, col[:, None] * inv_freq], axis=-1)


def apply_rope(x, ang):
    n_tok = ang.shape[0]
    cos = jnp.cos(ang).reshape(n_tok, 2, DH_C // 4)[None, :, None, None].astype(x.dtype)
    sin = jnp.sin(ang).reshape(n_tok, 2, DH_C // 4)[None, :, None, None].astype(x.dtype)
    xr = x.reshape(x.shape[:-1] + (2, 2, DH_C // 4))
    x1, x2 = xr[..., 0, :], xr[..., 1, :]
    out = jnp.stack([x1 * cos - x2 * sin, x2 * cos + x1 * sin], axis=-2)
    return out.reshape(x.shape)


def rwkv_streams(r, k, v, lw, la, decay_w0, decay_up, iclr_a0, iclr_up, k_k, k_a):
    kk = heads(k * k_k, H_A).astype(jnp.float32)
    kk = kk * lax.rsqrt(jnp.sum(kk * kk, axis=-1, keepdims=True) + 1e-12)
    dirs = []
    for d in range(2):
        w_raw = (decay_w0[d] + jnp.tanh(lw[d]) @ decay_up[d]).astype(jnp.float32)
        log_w = -jnp.exp(-jax.nn.softplus(-w_raw) - 0.5)
        a = jax.nn.sigmoid(iclr_a0[d] + la[d] @ iclr_up[d])
        k_dir = k * (1 + (a - 1) * k_a)
        dirs.append((heads(jnp.exp(log_w), H_A), heads(k_dir, H_A), heads(a, H_A) * kk))
    return heads(r, H_A), heads(k, H_A), heads(v, H_A), kk, dirs


def rwkv7_scan(r, v, kk, decay, k_dir, akk, state0, reverse):
    xs = tuple(jnp.swapaxes(t.astype(jnp.float32), 0, 1) for t in (r, v, kk, decay, k_dir, akk))

    def step(s, inp):
        r_t, v_t, kk_t, w_t, k_t, akk_t = inp
        s_kk = jnp.einsum('bhvk,bhk->bhv', s, kk_t)
        s = s * w_t[:, :, None, :] - s_kk[..., None] * akk_t[:, :, None, :] + v_t[..., None] * k_t[:, :, None, :]
        return s, jnp.einsum('bhvk,bhk->bhv', s, r_t)

    s_fin, ys = lax.scan(step, state0, xs, reverse=reverse)
    return jnp.swapaxes(ys, 0, 1).astype(r.dtype), s_fin


def rwkv_output(y, r, k, v, r_k, gn_g, gn_b):
    yf = y.astype(jnp.float32)
    mu = jnp.mean(yf, axis=-1, keepdims=True)
    var = jnp.mean(jnp.square(yf - mu), axis=-1, keepdims=True)
    yn = ((yf - mu) * lax.rsqrt(var + GN_EPS)).astype(y.dtype)
    bonus = jnp.sum(r * k * r_k, axis=-1, keepdims=True) * v
    flat = lambda t: t.reshape(t.shape[:-2] + (D_A,))
    return flat(yn) * gn_g + gn_b + flat(bonus)


def short_conv(u, conv_w, conv_b):
    n_tok = u.shape[1]
    up = jnp.pad(u, ((0, 0), (1, 1), (0, 0)))
    return up[:, :n_tok] * conv_w[0] + up[:, 1:n_tok + 1] * conv_w[1] + up[:, 2:] * conv_w[2] + conv_b


def qk_heads(t):
    return t.reshape(t.shape[:-1] + (H_C, 2, DH_C))


def diff_attend(q, k, v, lam):
    s = jnp.einsum('bqhcd,bkhcd->bhcqk', q, k).astype(jnp.float32) * (DH_C ** -0.5)
    p = jax.nn.softmax(s, axis=-1)
    attn = p[:, :, 0] - lam * p[:, :, 1]
    return jnp.einsum('bhqk,bkhv->bqhv', attn.astype(v.dtype), v)


def diff_out(o, subln_g, lam_init):
    o = rms_norm(o, subln_g) * (1 - lam_init)
    return o.reshape(o.shape[:-2] + (D_C,))


def merge_branches(y_a, y_b, y_c, z_a, z_b, z_c, g_merge, w_branch, w_out):
    y = jnp.stack([y_a * jax.nn.silu(z_a), y_b * jax.nn.silu(z_b), y_c * jax.nn.silu(z_c)], axis=-2)
    br = jnp.einsum('btiw,iwd->btid', y, w_branch)
    gates = jax.nn.sigmoid(g_merge.reshape(g_merge.shape[:-1] + (N_BRANCH, D_MODEL)))
    return jnp.sum(gates * br, axis=-2) @ w_out


def hybrid_layer(x, ctx, c, c_ctx, lam_init, update_ctx, w_mod, b_mod, norm_g, w_in,
                 decay_w0, decay_up, iclr_a0, iclr_up, k_k, k_a, r_k, gn_g, gn_b,
                 conv_w, conv_b, qk_norm_g, lambda_qk, subln_g, w_branch, w_out):
    bsz, n_tok, _ = x.shape
    h, gate = adaln_modulate(x, norm_g, c[:, None, :], w_mod, b_mod)
    hc, gate_c = adaln_modulate(ctx, norm_g, c_ctx[None, None, :], w_mod, b_mod)
    (r, k, v, lwf, lwb, laf, lab, z_a, gb, gc, u, z_b, qd, kd, vd, z_c, g_merge) = split_columns(h @ w_in)
    (r_c, k_c, v_c, lwf_c, lwb_c, laf_c, lab_c, z_a_c, gb_c, gc_c, u_c, z_b_c,
     qd_c, kd_c, vd_c, z_c_c, g_merge_c) = split_columns(hc @ w_in)

    rh, kh, vh, kk, dirs = rwkv_streams(r, k, v, (lwf, lwb), (laf, lab), decay_w0, decay_up, iclr_a0, iclr_up, k_k, k_a)
    rh_c, kh_c, vh_c, kk_c, dirs_c = rwkv_streams(r_c, k_c, v_c, (lwf_c, lwb_c), (laf_c, lab_c),
                                                  decay_w0, decay_up, iclr_a0, iclr_up, k_k, k_a)
    s0 = jnp.zeros((bsz, H_A, N_A, N_A), jnp.float32)
    yc_f, sc_f = rwkv7_scan(rh_c, vh_c, kk_c, *dirs_c[0], s0, False)
    yc_b, sc_b = rwkv7_scan(rh_c, vh_c, kk_c, *dirs_c[1], s0, True)
    y_f, _ = rwkv7_scan(rh, vh, kk, *dirs[0], sc_f, False)
    y_b, _ = rwkv7_scan(rh, vh, kk, *dirs[1], sc_b, True)
    y_a = rwkv_output(y_f + y_b, rh, kh, vh, r_k, gn_g, gn_b)

    y_bc = gb * short_conv(gc * u, conv_w, conv_b)

    lam = (jnp.exp(jnp.sum(lambda_qk[0] * lambda_qk[1]).astype(jnp.float32))
           - jnp.exp(jnp.sum(lambda_qk[2] * lambda_qk[3]).astype(jnp.float32)) + lam_init)
    ang = axial_rope_angles(n_tok)
    q = apply_rope(rms_norm(qk_heads(qd), qk_norm_g[0]), ang)
    kl = apply_rope(rms_norm(qk_heads(kd), qk_norm_g[1]), ang)
    kc_att = rms_norm(qk_heads(kd_c), qk_norm_g[1])
    vc_att = heads(vd_c, H_C)
    k_all = jnp.concatenate([kl, kc_att], axis=1)
    v_all = jnp.concatenate([heads(vd, H_C), vc_att], axis=1)
    n_blk = n_tok // Q_BLOCK
    qb = jnp.swapaxes(q.reshape(bsz, n_blk, Q_BLOCK, H_C, 2, DH_C), 0, 1)
    ob = lax.map(lambda qi: diff_attend(qi, k_all, v_all, lam), qb)
    o = jnp.swapaxes(ob, 0, 1).reshape(bsz, n_tok, H_C, DV_C)
    y_c = diff_out(o, subln_g, lam_init)

    x = x + gate * merge_branches(y_a, y_bc, y_c, z_a, z_b, z_c, g_merge, w_branch, w_out)

    if update_ctx:
        y_a_c = rwkv_output(yc_f + yc_b, rh_c, kh_c, vh_c, r_k, gn_g, gn_b)
        y_b_c = gb_c * short_conv(gc_c * u_c, conv_w, conv_b)
        q_c = rms_norm(qk_heads(qd_c), qk_norm_g[0])
        y_c_c = diff_out(diff_attend(q_c, kc_att, vc_att, lam), subln_g, lam_init)
        ctx = ctx + gate_c * merge_branches(y_a_c, y_b_c, y_c_c, z_a_c, z_b_c, z_c_c, g_merge_c, w_branch, w_out)
    return x, ctx


def setup_inputs(seed: int = 0) -> dict:
    key = jax.random.key(seed)
    ks = jax.random.split(key, 26)
    L, D = DEPTH, D_MODEL

    def nrm(k, shape, scale):
        return jax.random.normal(k, shape, jnp.float32) * scale

    return {
        "x": nrm(ks[0], (BATCH, SEQ, D), 1.0),
        "c": nrm(ks[1], (BATCH, D), 1.0),
        "ctx": nrm(ks[2], (BATCH, CTX_LEN, D), 1.0),
        "c_ctx": nrm(ks[3], (D,), 1.0),
        "w_mod": nrm(ks[4], (L, D, 3 * D), 0.5 * D ** -0.5),
        "b_mod": nrm(ks[5], (L, 3 * D), 0.02),
        "norm_g": 1.0 + nrm(ks[6], (L, D), 0.02),
        "w_in": nrm(ks[7], (L, D, N_IN), D ** -0.5),
        "decay_w0": jax.random.uniform(ks[8], (L, 2, D_A), jnp.float32, -5.0, 1.0),
        "decay_up": nrm(ks[9], (L, 2, R_DECAY, D_A), 0.1 * R_DECAY ** -0.5),
        "iclr_a0": nrm(ks[10], (L, 2, D_A), 0.5),
        "iclr_up": nrm(ks[11], (L, 2, R_ICLR, D_A), 0.1 * R_ICLR ** -0.5),
        "k_k": 0.85 + nrm(ks[12], (L, D_A), 0.05),
        "k_a": 1.0 + nrm(ks[13], (L, D_A), 0.05),
        "r_k": nrm(ks[14], (L, H_A, N_A), 0.1),
        "gn_g": 1.0 + nrm(ks[15], (L, D_A), 0.02),
        "gn_b": nrm(ks[16], (L, D_A), 0.02),
        "conv_w": nrm(ks[17], (L, CONV_K, D_B), CONV_K ** -0.5),
        "conv_b": nrm(ks[18], (L, D_B), 0.02),
        "qk_norm_g": 1.0 + nrm(ks[19], (L, 2, DH_C), 0.02),
        "lambda_qk": nrm(ks[20], (L, 4, DH_C), 0.1),
        "subln_g": 1.0 + nrm(ks[21], (L, DV_C), 0.02),
        "w_branch": nrm(ks[22], (L, N_BRANCH, BR_W, D), BR_W ** -0.5),
        "w_out": nrm(ks[23], (L, D, D), D ** -0.5),
    }


def reference(x, c, ctx, c_ctx, w_mod, b_mod, norm_g, w_in, decay_w0, decay_up, iclr_a0, iclr_up,
              k_k, k_a, r_k, gn_g, gn_b, conv_w, conv_b, qk_norm_g, lambda_qk, subln_g, w_branch, w_out):
    for l in range(DEPTH):
        lam_init = 0.8 - 0.6 * math.exp(-0.3 * l)
        x, ctx = hybrid_layer(x, ctx, c, c_ctx, lam_init, l < DEPTH - 1,
                              w_mod[l], b_mod[l], norm_g[l], w_in[l],
                              decay_w0[l], decay_up[l], iclr_a0[l], iclr_up[l], k_k[l], k_a[l], r_k[l],
                              gn_g[l], gn_b[l], conv_w[l], conv_b[l], qk_norm_g[l], lambda_qk[l],
                              subln_g[l], w_branch[l], w_out[l])
    return x
```

```cpp
#include <hip/hip_runtime.h>
#include <hip/hip_cooperative_groups.h>
#include <cstdio>
#include <cstdint>
namespace cg = cooperative_groups;

typedef unsigned short bf16_t;
typedef short bf16x8 __attribute__((ext_vector_type(8)));
typedef float f32x4 __attribute__((ext_vector_type(4)));
typedef float f32x2 __attribute__((ext_vector_type(2)));
typedef unsigned u32x4 __attribute__((ext_vector_type(4)));
typedef unsigned u32x2 __attribute__((ext_vector_type(2)));

constexpr int D = 1024, NB = 8, T = 4096, NL = 4, CTX = 256, S = T + CTX, M = NB * S, NP = 6400, NIN = 9472;
constexpr int C_R = 0, C_K = 512, C_V = 1024, C_LWF = 1536, C_LWB = 1600, C_LAF = 1664, C_LAB = 1728, C_ZA = 1792,
              C_GB = 2304, C_GC = 2816, C_U = 3328, C_ZB = 3840, C_QD = 4352, C_KD = 4864, C_VD = 5376, C_ZC = 5888;
constexpr int C_YA = C_R, C_YB = C_GB, C_YC = C_QD, C_M0 = C_ZB, C_M1 = C_VD, C_YSF = C_GC, C_YSB = C_U, C_KK = C_ZB;
constexpr int NTHR = 512;
constexpr size_t WSET = (size_t)NP * D + (size_t)3072 * D + (size_t)3 * D * 512 + (size_t)D * D;
constexpr int LDS_BYTES = 147456;

struct Params {
  const float *x, *c, *ctx, *c_ctx, *w_mod, *b_mod, *norm_g, *w_in, *decay_w0, *decay_up, *iclr_a0, *iclr_up, *k_k, *k_a, *r_k,
      *gn_g, *gn_b, *conv_w, *conv_b, *qk_norm_g, *lambda_qk, *subln_g, *w_branch, *w_out;
  float* out;
  char* ws;
};
constexpr size_t al256(size_t x) { return (x + 255) & ~(size_t)255; }
constexpr size_t WSET_C = (size_t)NP * D + (size_t)3072 * D + (size_t)3 * D * 512 + (size_t)D * D;
constexpr size_t OFF_PROJ = 0;
constexpr size_t OFF_H = OFF_PROJ + al256((size_t)M * NP * 2);
constexpr size_t OFF_VT = OFF_H + al256((size_t)M * D * 2);
constexpr size_t OFF_W = OFF_VT + al256((size_t)NB * 4 * 128 * S * 2);
constexpr size_t OFF_CTXS = OFF_W + al256(2 * WSET_C * 2);
constexpr size_t OFF_MOD = OFF_CTXS + al256((size_t)NB * CTX * D * 4);
constexpr size_t OFF_BAR = OFF_MOD + al256((size_t)NL * 9 * 3072 * 4);
constexpr size_t WS_TOTAL = OFF_BAR + 256;
#define WS_PROJ(p) ((bf16_t*)((p).ws + OFF_PROJ))
#define WS_H(p) ((bf16_t*)((p).ws + OFF_H))
#define WS_VT(p) ((bf16_t*)((p).ws + OFF_VT))
#define WS_WIN(p) ((bf16_t*)((p).ws + OFF_W))
#define WS_WG(p) (WS_WIN(p) + (size_t)NP * D)
#define WS_WB(p) (WS_WG(p) + (size_t)3072 * D)
#define WS_WO(p) (WS_WB(p) + (size_t)3 * D * 512)
#define WS_CTXS(p) ((float*)((p).ws + OFF_CTXS))
#define WS_MOD(p) ((float*)((p).ws + OFF_MOD))
#define WS_BAR(p) ((unsigned*)((p).ws + OFF_BAR))

__device__ __forceinline__ int opaque_tid() { int t = threadIdx.x; asm volatile("" : "+v"(t)); return t; }
__device__ __forceinline__ float bf_lo(unsigned u) { return __uint_as_float(u << 16); }
__device__ __forceinline__ float bf_hi(unsigned u) { return __uint_as_float(u & 0xffff0000u); }
__device__ __forceinline__ unsigned pack_bf16(float lo, float hi) {
  unsigned r;
  asm("s_nop 0\n\tv_cvt_pk_bf16_f32 %0, %1, %2" : "=v"(r) : "v"(lo), "v"(hi));
  return r;
}
__device__ __forceinline__ float vmul_(float a, float b) { float d; asm("v_mul_f32 %0, %1, %2" : "=v"(d) : "v"(a), "v"(b)); return d; }
__device__ __forceinline__ float vfma_(float a, float b, float c) { float d; asm("v_fma_f32 %0, %1, %2, %3" : "=v"(d) : "v"(a), "v"(b), "v"(c)); return d; }
__device__ __forceinline__ float vfnma_(float a, float b, float c) { float d; asm("v_fma_f32 %0, -%1, %2, %3" : "=v"(d) : "v"(a), "v"(b), "v"(c)); return d; }
typedef __bf16 bf16v2_t __attribute__((ext_vector_type(2)));
__device__ __forceinline__ unsigned pack_bf16_b(float lo, float hi) {
  const f32x2 v = {lo, hi};
  return __builtin_bit_cast(unsigned, __builtin_convertvector(v, bf16v2_t));
}
__device__ __forceinline__ f32x4 mfma_guard(f32x4 v) { return v + (f32x4){0.f, 0.f, 0.f, 0.f}; }
__device__ __forceinline__ float sigmoidf_(float x) { return __builtin_amdgcn_rcpf(1.f + __expf(-x)); }
__device__ __forceinline__ float siluf_(float x) { return x * sigmoidf_(x); }
__device__ __forceinline__ float tanhf_(float x) { return 1.f - 2.f * __builtin_amdgcn_rcpf(__expf(2.f * x) + 1.f); }
template <int CTRL> __device__ __forceinline__ float dppf(float x) {
  return __int_as_float(__builtin_amdgcn_update_dpp(0, __float_as_int(x), CTRL, 0xF, 0xF, true));
}
__device__ __forceinline__ float allreduce8(float x) {
  x += dppf<0xB1>(x);
  x += dppf<0x4E>(x);
  x += dppf<0x141>(x);
  return x;
}
__device__ __forceinline__ float grp8_sum(float v) { return allreduce8(v); }
__device__ __forceinline__ float wave_sum(float v) {
  v = allreduce8(v);
  v += dppf<0x140>(v);
  return __int_as_float(__builtin_amdgcn_readlane(__float_as_int(v), 0)) + __int_as_float(__builtin_amdgcn_readlane(__float_as_int(v), 16)) +
         __int_as_float(__builtin_amdgcn_readlane(__float_as_int(v), 32)) + __int_as_float(__builtin_amdgcn_readlane(__float_as_int(v), 48));
}
__device__ __forceinline__ float wave_max(float v) {
  v = fmaxf(v, dppf<0xB1>(v));
  v = fmaxf(v, dppf<0x4E>(v));
  v = fmaxf(v, dppf<0x141>(v));
  v = fmaxf(v, dppf<0x140>(v));
  return fmaxf(fmaxf(__int_as_float(__builtin_amdgcn_readlane(__float_as_int(v), 0)), __int_as_float(__builtin_amdgcn_readlane(__float_as_int(v), 16))),
               fmaxf(__int_as_float(__builtin_amdgcn_readlane(__float_as_int(v), 32)), __int_as_float(__builtin_amdgcn_readlane(__float_as_int(v), 48))));
}
__device__ __forceinline__ float shflx(float v, int mask, int lane) {
  return __int_as_float(__builtin_amdgcn_ds_bpermute((lane ^ mask) << 2, __float_as_int(v)));
}
#define UNPACK8(raw, f)                                                                                  \
  {                                                                                                      \
    f[0] = bf_lo(raw.x); f[1] = bf_hi(raw.x); f[2] = bf_lo(raw.y); f[3] = bf_hi(raw.y);                  \
    f[4] = bf_lo(raw.z); f[5] = bf_hi(raw.z); f[6] = bf_lo(raw.w); f[7] = bf_hi(raw.w);                  \
  }
#define PACK8(f) ((u32x4){pack_bf16(f[0], f[1]), pack_bf16(f[2], f[3]), pack_bf16(f[4], f[5]), pack_bf16(f[6], f[7])})

constexpr int G_STAGE = 55296, G_BOFF = 36864;
__device__ __forceinline__ void gemm_256x128(const bf16_t* A, int lda, const bf16_t* Bt, int ldb, int K,
                                             f32x4 (&acc)[4][4], char* lds, const int tid) {
  const int lane = tid & 63, wid = tid >> 6, wm = wid >> 1, wn = wid & 1, fr = lane & 15, fq = lane >> 4;
  const int srow = tid >> 3, sch = tid & 7;
  const bf16_t* ag = A + (size_t)srow * lda + sch * 8;
  const bf16_t* bg = Bt + (size_t)srow * ldb + sch * 8;
  u32x4 ra[4], rb[2];
  const int nk = K >> 6;
#pragma unroll
  for (int i = 0; i < 4; ++i) ra[i] = *(const u32x4*)(ag + (size_t)(64 * i) * lda);
#pragma unroll
  for (int i = 0; i < 2; ++i) rb[i] = *(const u32x4*)(bg + (size_t)(64 * i) * ldb);
#pragma unroll
  for (int i = 0; i < 4; ++i) *(u32x4*)(lds + (srow + 64 * i) * 144 + sch * 16) = ra[i];
#pragma unroll
  for (int i = 0; i < 2; ++i) *(u32x4*)(lds + G_BOFF + (srow + 64 * i) * 144 + sch * 16) = rb[i];
  __syncthreads();
  for (int kt = 0; kt < nk; ++kt) {
    const bool more = (kt + 1 < nk);
    if (more) {
#pragma unroll
      for (int i = 0; i < 4; ++i) ra[i] = *(const u32x4*)(ag + (size_t)(64 * i) * lda + (kt + 1) * 64);
#pragma unroll
      for (int i = 0; i < 2; ++i) rb[i] = *(const u32x4*)(bg + (size_t)(64 * i) * ldb + (kt + 1) * 64);
    }
    const char* base = lds + (kt & 1) * G_STAGE;
#pragma unroll
    for (int ks = 0; ks < 2; ++ks) {
      bf16x8 af[4], bfr[4];
#pragma unroll
      for (int mi = 0; mi < 4; ++mi) af[mi] = *(const bf16x8*)(base + (wm * 64 + mi * 16 + fr) * 144 + ks * 64 + fq * 16);
#pragma unroll
      for (int ni = 0; ni < 4; ++ni) bfr[ni] = *(const bf16x8*)(base + G_BOFF + (wn * 64 + ni * 16 + fr) * 144 + ks * 64 + fq * 16);
#pragma unroll
      for (int mi = 0; mi < 4; ++mi)
#pragma unroll
        for (int ni = 0; ni < 4; ++ni) acc[mi][ni] = __builtin_amdgcn_mfma_f32_16x16x32_bf16(bfr[ni], af[mi], acc[mi][ni], 0, 0, 0);
    }
    if (more) {
      char* nb = lds + ((kt + 1) & 1) * G_STAGE;
#pragma unroll
      for (int i = 0; i < 4; ++i) *(u32x4*)(nb + (srow + 64 * i) * 144 + sch * 16) = ra[i];
#pragma unroll
      for (int i = 0; i < 2; ++i) *(u32x4*)(nb + G_BOFF + (srow + 64 * i) * 144 + sch * 16) = rb[i];
    }
    __syncthreads();
  }
}

__device__ __forceinline__ void gemm_256x128_deep(const bf16_t* A, int lda, const bf16_t* Bt, int ldb, int K, f32x4 (&acc)[4][4], char* lds,
                                                  const int tid) {
  const int lane = tid & 63, wid = tid >> 6, wm = wid >> 1, wn = wid & 1, fr = lane & 15, fq = lane >> 4;
  const int srow = tid >> 3, sch = tid & 7;
  const bf16_t* ag = A + (size_t)srow * lda + sch * 8;
  const bf16_t* bg = Bt + (size_t)srow * ldb + sch * 8;
  u32x4 ra0[4], rb0[2], ra1[4], rb1[2];
  const int nk = K >> 6;
#define GLOAD(RA, RB, kt_)                                                                                  \
  {                                                                                                         \
    _Pragma("unroll") for (int i = 0; i < 4; ++i) RA[i] = *(const u32x4*)(ag + (size_t)(64 * i) * lda + (kt_) * 64); \
    _Pragma("unroll") for (int i = 0; i < 2; ++i) RB[i] = *(const u32x4*)(bg + (size_t)(64 * i) * ldb + (kt_) * 64); \
  }
#define LSTORE(RA, RB, st_)                                                                                 \
  {                                                                                                         \
    char* nb_ = lds + (st_) * G_STAGE;                                                                      \
    _Pragma("unroll") for (int i = 0; i < 4; ++i) *(u32x4*)(nb_ + (srow + 64 * i) * 144 + sch * 16) = RA[i]; \
    _Pragma("unroll") for (int i = 0; i < 2; ++i) *(u32x4*)(nb_ + G_BOFF + (srow + 64 * i) * 144 + sch * 16) = RB[i]; \
  }
#define GCOMPUTE(st_)                                                                                       \
  {                                                                                                         \
    const char* base_ = lds + (st_) * G_STAGE;                                                              \
    _Pragma("unroll") for (int ks = 0; ks < 2; ++ks) {                                                      \
      bf16x8 af[4], bfr[4];                                                                                 \
      _Pragma("unroll") for (int mi = 0; mi < 4; ++mi) af[mi] = *(const bf16x8*)(base_ + (wm * 64 + mi * 16 + fr) * 144 + ks * 64 + fq * 16); \
      _Pragma("unroll") for (int ni = 0; ni < 4; ++ni) bfr[ni] = *(const bf16x8*)(base_ + G_BOFF + (wn * 64 + ni * 16 + fr) * 144 + ks * 64 + fq * 16); \
      _Pragma("unroll") for (int mi = 0; mi < 4; ++mi)                                                      \
        _Pragma("unroll") for (int ni = 0; ni < 4; ++ni) acc[mi][ni] = __builtin_amdgcn_mfma_f32_16x16x32_bf16(bfr[ni], af[mi], acc[mi][ni], 0, 0, 0); \
    }                                                                                                       \
  }
  GLOAD(ra0, rb0, 0);
  LSTORE(ra0, rb0, 0);
  GLOAD(ra0, rb0, 1);
  __syncthreads();
#pragma unroll 1
  for (int kt = 0; kt < nk; kt += 2) {
    if (kt + 2 < nk) GLOAD(ra1, rb1, kt + 2);
    GCOMPUTE(0);
    LSTORE(ra0, rb0, 1);
    __syncthreads();
    if (kt + 3 < nk) GLOAD(ra0, rb0, kt + 3);
    GCOMPUTE(1);
    if (kt + 2 < nk) LSTORE(ra1, rb1, 0);
    __syncthreads();
  }
#undef GLOAD
#undef LSTORE
#undef GCOMPUTE
}

#define LAS __attribute__((address_space(3)))
constexpr int D_STAGE = 49152;
__device__ __forceinline__ int dma_lds_byte(int r, int c) {
  const int st = (r >> 4) * 2 + (c >> 5), rr = r & 15, cc = c & 31, ob = rr * 64 + cc * 2;
  return st * 1024 + (ob ^ (((ob >> 9) & 1) << 5));
}
__device__ __forceinline__ void dma_stage_rc(int b, int& R, int& C) {
  const int st = b / 1024, sb = b % 1024, swz = sb ^ (((sb >> 9) & 1) << 5);
  R = (st >> 1) * 16 + swz / 64;
  C = (st & 1) * 32 + (swz % 64) / 2;
}
__device__ __forceinline__ void gemm_256x128_dma(const bf16_t* A, int lda, const bf16_t* Bt, int ldb, int K, f32x4 (&acc)[4][4], char* lds,
                                                 const int tid, const int ksplit = 1 << 30, const int asplit_bytes = 0) {
  const int lane = tid & 63, wid = __builtin_amdgcn_readfirstlane(tid >> 6), wm = wid >> 1, wn = wid & 1, fr = lane & 15, fq = lane >> 4;
  unsigned voffA[2], voffB[2];
#pragma unroll
  for (int i = 0; i < 2; ++i) {
    int R, C;
    dma_stage_rc(tid * 16 + i * 8192, R, C);
    voffA[i] = (unsigned)(R * lda + C) * 2u;
    voffB[i] = (unsigned)(R * ldb + C) * 2u;
  }
  const char* Ab = (const char*)A;
  const char* Bb = (const char*)Bt;
  const size_t ahalf = (size_t)128 * lda * 2;
  LAS char* l3 = (LAS char*)lds;
  const unsigned ldsw = (unsigned)wid * 1024u;
  const int aoff = (wm >> 1) * 16384 + dma_lds_byte((wm & 1) * 64 + fr, fq * 8);
  const int boff = 32768 + dma_lds_byte(wn * 64 + fr, fq * 8);
  const int nk = K >> 6;
#define DMA_STAGE(kt_, sbase_)                                                                                               \
  {                                                                                                                          \
    const char* ga_ = Ab + (size_t)(kt_) * 128 + ((kt_) >= ksplit ? asplit_bytes : 0);                                                                              \
    const char* gb_ = Bb + (size_t)(kt_) * 128;                                                                              \
    _Pragma("unroll") for (int i_ = 0; i_ < 2; ++i_) {                                                                       \
      __builtin_amdgcn_global_load_lds((const unsigned*)(ga_ + voffA[i_]), (LAS unsigned*)(l3 + (sbase_) + ldsw + i_ * 8192), 16, 0, 0);          \
      __builtin_amdgcn_global_load_lds((const unsigned*)(ga_ + ahalf + voffA[i_]), (LAS unsigned*)(l3 + (sbase_) + 16384 + ldsw + i_ * 8192), 16, 0, 0); \
      __builtin_amdgcn_global_load_lds((const unsigned*)(gb_ + voffB[i_]), (LAS unsigned*)(l3 + (sbase_) + 32768 + ldsw + i_ * 8192), 16, 0, 0);  \
    }                                                                                                                        \
  }
  asm volatile("s_waitcnt vmcnt(0)" ::: "memory");
  DMA_STAGE(0, 0);
  DMA_STAGE(1, D_STAGE);
  asm volatile("s_waitcnt vmcnt(6)" ::: "memory");
  __builtin_amdgcn_s_barrier();
  int sc = 0, sn = 2 * D_STAGE;
#pragma unroll 1
  for (int kt = 0; kt < nk; ++kt) {
    const bool pre = kt + 2 < nk;
    if (pre) DMA_STAGE(kt + 2, sn);
    {
      const LAS char* base = l3 + sc;
#pragma unroll
      for (int ks = 0; ks < 2; ++ks) {
        bf16x8 af[4], bfr[4];
#pragma unroll
        for (int mi = 0; mi < 4; ++mi) af[mi] = *(const LAS bf16x8*)(base + aoff + mi * 2048 + ks * 1024);
#pragma unroll
        for (int ni = 0; ni < 4; ++ni) bfr[ni] = *(const LAS bf16x8*)(base + boff + ni * 2048 + ks * 1024);
        __builtin_amdgcn_sched_barrier(0);
#pragma unroll
        for (int mi = 0; mi < 4; ++mi)
#pragma unroll
          for (int ni = 0; ni < 4; ++ni) acc[mi][ni] = __builtin_amdgcn_mfma_f32_16x16x32_bf16(bfr[ni], af[mi], acc[mi][ni], 0, 0, 0);
      }
    }
    if (pre) asm volatile("s_waitcnt vmcnt(6)" ::: "memory");
    else asm volatile("s_waitcnt vmcnt(0)" ::: "memory");
    __builtin_amdgcn_s_barrier();
    sc = (sc == 2 * D_STAGE) ? 0 : sc + D_STAGE;
    sn = (sn == 2 * D_STAGE) ? 0 : sn + D_STAGE;
  }
#undef DMA_STAGE
}

__device__ __forceinline__ void gemm_256x256_dma(const bf16_t* A, int lda, const bf16_t* Bt, int ldb, int K, f32x4 (&acc)[8][4], char* lds,
                                                 const int tid) {
  const int lane = tid & 63, wid = __builtin_amdgcn_readfirstlane(tid >> 6), wm = wid >> 2, wn = wid & 3, fr = lane & 15, fq = lane >> 4;
  unsigned voffA[2], voffB[2];
#pragma unroll
  for (int i = 0; i < 2; ++i) {
    int R, C;
    dma_stage_rc(tid * 16 + i * 8192, R, C);
    voffA[i] = (unsigned)(R * lda + C) * 2u;
    voffB[i] = (unsigned)(R * ldb + C) * 2u;
  }
  const char* Ab = (const char*)A;
  const char* Bb = (const char*)Bt;
  const size_t ahalf = (size_t)128 * lda * 2, bhalf = (size_t)128 * ldb * 2;
  LAS char* l3 = (LAS char*)lds;
  const unsigned ldsw = (unsigned)wid * 1024u;
  const int aoff = wm * 16384 + dma_lds_byte(fr, fq * 8);
  const int boff = 32768 + (wn >> 1) * 16384 + dma_lds_byte((wn & 1) * 64 + fr, fq * 8);
  const int nk = K >> 6;
#define DMA_STAGE4(kt_, sbase_)                                                                                              \
  {                                                                                                                          \
    const char* ga_ = Ab + (size_t)(kt_) * 128;                                                                              \
    const char* gb_ = Bb + (size_t)(kt_) * 128;                                                                              \
    _Pragma("unroll") for (int i_ = 0; i_ < 2; ++i_) {                                                                       \
      __builtin_amdgcn_global_load_lds((const unsigned*)(ga_ + voffA[i_]), (LAS unsigned*)(l3 + (sbase_) + ldsw + i_ * 8192), 16, 0, 0);          \
      __builtin_amdgcn_global_load_lds((const unsigned*)(ga_ + ahalf + voffA[i_]), (LAS unsigned*)(l3 + (sbase_) + 16384 + ldsw + i_ * 8192), 16, 0, 0); \
      __builtin_amdgcn_global_load_lds((const unsigned*)(gb_ + voffB[i_]), (LAS unsigned*)(l3 + (sbase_) + 32768 + ldsw + i_ * 8192), 16, 0, 0);  \
      __builtin_amdgcn_global_load_lds((const unsigned*)(gb_ + bhalf + voffB[i_]), (LAS unsigned*)(l3 + (sbase_) + 49152 + ldsw + i_ * 8192), 16, 0, 0); \
    }                                                                                                                        \
  }
  asm volatile("s_waitcnt vmcnt(0)" ::: "memory");
  DMA_STAGE4(0, 0);
  asm volatile("s_waitcnt vmcnt(0)" ::: "memory");
  __builtin_amdgcn_s_barrier();
#pragma unroll 1
  for (int kt = 0; kt < nk; ++kt) {
    const int sc = (kt & 1) * 65536;
    if (kt + 1 < nk) DMA_STAGE4(kt + 1, 65536 - sc);
    {
      const LAS char* base = l3 + sc;
#pragma unroll
      for (int ks = 0; ks < 2; ++ks) {
        bf16x8 af[8], bfr[4];
#pragma unroll
        for (int ni = 0; ni < 4; ++ni) bfr[ni] = *(const LAS bf16x8*)(base + boff + ni * 2048 + ks * 1024);
#pragma unroll
        for (int mi = 0; mi < 8; ++mi) af[mi] = *(const LAS bf16x8*)(base + aoff + mi * 2048 + ks * 1024);
        __builtin_amdgcn_sched_barrier(0);
#pragma unroll
        for (int mi = 0; mi < 8; ++mi)
#pragma unroll
          for (int ni = 0; ni < 4; ++ni) acc[mi][ni] = __builtin_amdgcn_mfma_f32_16x16x32_bf16(bfr[ni], af[mi], acc[mi][ni], 0, 0, 0);
      }
    }
    asm volatile("s_waitcnt vmcnt(0)" ::: "memory");
    __builtin_amdgcn_s_barrier();
  }
#undef DMA_STAGE4
}

__device__ void phase_mod(const Params& p, char* lds) {
  const int tid = opaque_tid();
  float* sc = (float*)lds;
  for (int i = tid; i < 9 * 1024; i += NTHR) {
    int s = i >> 10, k = i & 1023;
    float v = s < 8 ? p.c[s * 1024 + k] : p.c_ctx[k];
    sc[i] = siluf_(v);
  }
  __syncthreads();
  float* red = sc + 9 * 1024;
  for (int u = blockIdx.x; u < NL * 48; u += gridDim.x) {
    const int l = u / 48, n0 = (u % 48) * 64, col = tid & 63, kq = tid >> 6;
    const float* w = p.w_mod + (size_t)l * 1024 * 3072 + (size_t)(kq * 128) * 3072 + n0 + col;
    float a[9];
#pragma unroll
    for (int s = 0; s < 9; ++s) a[s] = 0.f;
#pragma unroll 4
    for (int k = 0; k < 128; ++k) {
      float wv = w[(size_t)k * 3072];
#pragma unroll
      for (int s = 0; s < 9; ++s) a[s] += sc[s * 1024 + kq * 128 + k] * wv;
    }
#pragma unroll
    for (int s = 0; s < 9; ++s) red[(kq * 64 + col) * 9 + s] = a[s];
    __syncthreads();
    for (int o = tid; o < 576; o += NTHR) {
      int cc = o / 9, s = o % 9;
      float t = 0.f;
#pragma unroll
      for (int q = 0; q < 8; ++q) t += red[(q * 64 + cc) * 9 + s];
      WS_MOD(p)[((size_t)l * 9 + s) * 3072 + n0 + cc] = t + p.b_mod[l * 3072 + n0 + cc];
    }
    __syncthreads();
  }
}

__device__ __forceinline__ void cvt_tile(const float* src, int ldsrc, bf16_t* dst, int K, int k0, int n0, float* tl, const int tid) {
#pragma unroll
  for (int i = 0; i < 2; ++i) {
    int kk = (tid >> 4) + 32 * i, nn = (tid & 15) * 4;
    f32x4 v = *(const f32x4*)(src + (size_t)(k0 + kk) * ldsrc + n0 + nn);
    tl[kk * 65 + nn + 0] = v.x; tl[kk * 65 + nn + 1] = v.y; tl[kk * 65 + nn + 2] = v.z; tl[kk * 65 + nn + 3] = v.w;
  }
  __syncthreads();
  {
    int n = tid >> 3, k8 = (tid & 7) * 8;
    float f[8];
#pragma unroll
    for (int e = 0; e < 8; ++e) f[e] = tl[(k8 + e) * 65 + n];
    *(u32x4*)(dst + (size_t)(n0 + n) * K + k0 + k8) = PACK8(f);
  }
  __syncthreads();
}
__device__ void phase_cvt(const Params& p, int l, char* lds, int rank, int stride) {
  const int tid = opaque_tid();
  float* tl = (float*)lds;
  const size_t wso = (size_t)(l & 1) * WSET;
  const float* win = p.w_in + (size_t)l * D * NIN;
  const float* wbr = p.w_branch + (size_t)l * 3 * 512 * D;
  const float* wo = p.w_out + (size_t)l * D * D;
  for (int u = rank; u < 3008; u += stride) {
    if (u < 2368) {
      int kt = u / 148, nt = u % 148;
      if (nt < 100) cvt_tile(win, NIN, WS_WIN(p) + wso, D, kt * 64, nt * 64, tl, tid);
      else cvt_tile(win + 6400, NIN, WS_WG(p) + wso, D, kt * 64, (nt - 100) * 64, tl, tid);
    } else if (u < 2368 + 384) {
      int v = u - 2368, i = v / 128, r = v % 128, kt = r / 16, nt = r % 16;
      cvt_tile(wbr + (size_t)i * 512 * D, D, WS_WB(p) + wso + (size_t)i * D * 512, 512, kt * 64, nt * 64, tl, tid);
    } else {
      int v = u - 2752, kt = v / 16, nt = v % 16;
      cvt_tile(wo, D, WS_WO(p) + wso, D, kt * 64, nt * 64, tl, tid);
    }
  }
}

__device__ __forceinline__ const float* xrow_src(const Params& p, int l, int b, int s) {
  return (s < CTX) ? ((l == 0 ? p.ctx : WS_CTXS(p)) + ((size_t)b * CTX + s) * D) : ((l == 0 ? p.x : p.out) + ((size_t)b * T + (s - CTX)) * D);
}
__device__ void phase_norm(const Params& p, int l) {
  const int tid = opaque_tid();
  const int gw = blockIdx.x * 8 + (tid >> 6), nw = gridDim.x * 8, lane = tid & 63;
  const float* ng = p.norm_g + l * D;
  for (int row = gw; row < M; row += nw) {
    const int b = row / S, s = row % S;
    const float* xr = xrow_src(p, l, b, s);
#ifndef PROBE_NORM
#define PROBE_NORM 0
#endif
    const float* md = WS_MOD(p) + ((size_t)(PROBE_NORM == 1 ? 0 : l) * 9 + (s < CTX ? 8 : b)) * 3072;
    f32x4 v[4];
    float ss = 0.f;
#pragma unroll
    for (int i = 0; i < 4; ++i) {
      v[i] = *(const f32x4*)(xr + i * 256 + lane * 4);
      ss += v[i].x * v[i].x + v[i].y * v[i].y + v[i].z * v[i].z + v[i].w * v[i].w;
    }
    ss = wave_sum(ss);
    const float rstd = rsqrtf(ss * (1.f / 1024.f) + 1e-6f);
#pragma unroll
    for (int i = 0; i < 4; ++i) {
      const int col = i * 256 + lane * 4;
      f32x4 g = *(const f32x4*)(ng + col), sh = *(const f32x4*)(md + col), sc = *(const f32x4*)(md + 1024 + col);
      f32x4 y = v[i] * rstd * g * (1.f + sc) + sh;
      u32x2 o = {pack_bf16(y.x, y.y), pack_bf16(y.z, y.w)};
      *(u32x2*)(WS_H(p) + (size_t)row * D + col) = o;
    }
  }
}

__device__ void phase_inproj(const Params& p, int l, char* lds) {
  const int tid = opaque_tid(), lane = tid & 63, wid = tid >> 6, wm = wid >> 2, wn = wid & 3, fr = lane & 15, fq = lane >> 4;
  const int xcd = blockIdx.x & 7, bi = blockIdx.x >> 3, nbx = (gridDim.x + 7 - xcd) >> 3;
  for (int idx = bi; idx < 17 * 25; idx += nbx) {
    int ml, nl, mg, ng;
    if (idx < 400) {
      mg = idx / 100;
      const int rem = idx - mg * 100;
      ng = rem >> 5;
      const int rem2 = rem & 31;
      if (ng < 3) { ml = rem2 & 3; nl = rem2 >> 2; } else { ml = rem2; nl = 0; }
    } else { mg = 4; ng = 0; ml = 0; nl = idx - 400; }
    const int mt = 17 * xcd + mg * 4 + ml, nt = ng * 8 + nl;
    f32x4 acc[8][4];
#pragma unroll
    for (int mi = 0; mi < 8; ++mi)
#pragma unroll
      for (int ni = 0; ni < 4; ++ni) acc[mi][ni] = (f32x4){0.f, 0.f, 0.f, 0.f};
    gemm_256x256_dma(WS_H(p) + (size_t)mt * 256 * D, D, WS_WIN(p) + (size_t)(l & 1) * WSET + (size_t)nt * 256 * D, D, D, acc, lds, tid);
    const bool dotanh = (nt == 6) && (wn < 2);
    char* wl = lds + wid * 18432;
#pragma unroll
    for (int mi = 0; mi < 8; ++mi)
#pragma unroll
      for (int ni = 0; ni < 4; ++ni) {
        f32x4 v = mfma_guard(acc[mi][ni]);
        if (dotanh) { v.x = tanhf_(v.x); v.y = tanhf_(v.y); v.z = tanhf_(v.z); v.w = tanhf_(v.w); }
        const u32x2 o = {pack_bf16(v.x, v.y), pack_bf16(v.z, v.w)};
        *(u32x2*)(wl + (mi * 16 + fr) * 144 + (ni * 16 + 4 * fq) * 2) = o;
      }
    {
      const int rr = lane >> 3, cc = lane & 7;
      bf16_t* gbase = WS_PROJ(p) + (size_t)(mt * 256 + wm * 128) * NP + nt * 256 + wn * 64 + cc * 8;
#pragma unroll
      for (int j = 0; j < 16; ++j) {
        const int r = j * 8 + rr;
        const u32x4 o = *(const u32x4*)(wl + r * 144 + cc * 16);
        *(u32x4*)(gbase + (size_t)r * NP) = o;
      }
    }
    __syncthreads();
  }
}

__device__ __forceinline__ void prep_token(const Params& p, int l, int row, int lane) {
  const int s = row % S;
  const bool lat = s >= CTX;
  const int t = s - CTX;
  bf16_t* pr = WS_PROJ(p) + (size_t)row * NP;
  const int gi = lane & 7, d0 = gi * 8;
  float cs[8], sn[8];
  if (lat) {
    const float pos = (gi >> 2) ? (float)(t & 63) : (float)(t >> 6);
#pragma unroll
    for (int e = 0; e < 8; ++e) {
      float fr_ = __builtin_amdgcn_exp2f(-(float)((gi & 1) * 8 + e) * 0.830482024f);
      float rev = pos * fr_ * 0.15915494309f;
      rev = rev - floorf(rev);
      cs[e] = __builtin_amdgcn_cosf(rev);
      sn[e] = __builtin_amdgcn_sinf(rev);
    }
  } else {
#pragma unroll
    for (int e = 0; e < 8; ++e) { cs[e] = 1.f; sn[e] = 0.f; }
  }
  const float sgn = ((gi >> 1) & 1) ? 1.f : -1.f;
#pragma unroll
  for (int which = 0; which < 2; ++which) {
    bf16_t* ptr = pr + (which ? C_KD : C_QD) + lane * 8;
    const float* g = p.qk_norm_g + l * 128 + which * 64 + d0;
    u32x4 raw = *(const u32x4*)ptr;
    float x[8], y[8];
    UNPACK8(raw, x);
    float ss = 0.f;
#pragma unroll
    for (int e = 0; e < 8; ++e) ss += x[e] * x[e];
    ss = grp8_sum(ss);
    const float rstd = rsqrtf(ss * (1.f / 64.f) + 1e-6f);
    const float osc = which ? 1.f : 0.18033688011f;
#pragma unroll
    for (int e = 0; e < 8; ++e) y[e] = x[e] * rstd * g[e];
#pragma unroll
    for (int e = 0; e < 8; ++e) {
      float pv = dppf<0x4E>(y[e]);
      x[e] = (y[e] * cs[e] + sgn * pv * sn[e]) * osc;
    }
    *(u32x4*)ptr = PACK8(x);
  }
  u32x4 kkp;
  {
    u32x4 raw = *(const u32x4*)(pr + C_K + lane * 8);
    float x[8];
    UNPACK8(raw, x);
    const float* kkw = p.k_k + l * 512 + lane * 8;
    float ss = 0.f;
#pragma unroll
    for (int e = 0; e < 8; ++e) { x[e] *= kkw[e]; ss += x[e] * x[e]; }
    ss = grp8_sum(ss);
    const float rn = rsqrtf(ss + 1e-12f);
#pragma unroll
    for (int e = 0; e < 8; ++e) x[e] *= rn;
    kkp = PACK8(x);
  }
  {
    const int sp = lat ? t : s, sl = lat ? T : CTX;
    float gb[8], zb[8], g0[8], u0[8], gm[8], um[8], gp[8], up[8];
    u32x4 raw;
    raw = *(const u32x4*)(pr + C_GB + lane * 8); UNPACK8(raw, gb);
    raw = *(const u32x4*)(pr + C_ZB + lane * 8); UNPACK8(raw, zb);
    raw = *(const u32x4*)(pr + C_GC + lane * 8); UNPACK8(raw, g0);
    raw = *(const u32x4*)(pr + C_U + lane * 8); UNPACK8(raw, u0);
    if (sp > 0) {
      raw = *(const u32x4*)(pr - NP + C_GC + lane * 8); UNPACK8(raw, gm);
      raw = *(const u32x4*)(pr - NP + C_U + lane * 8); UNPACK8(raw, um);
    } else {
#pragma unroll
      for (int e = 0; e < 8; ++e) { gm[e] = 0.f; um[e] = 0.f; }
    }
    if (sp < sl - 1) {
      raw = *(const u32x4*)(pr + NP + C_GC + lane * 8); UNPACK8(raw, gp);
      raw = *(const u32x4*)(pr + NP + C_U + lane * 8); UNPACK8(raw, up);
    } else {
#pragma unroll
      for (int e = 0; e < 8; ++e) { gp[e] = 0.f; up[e] = 0.f; }
    }
    const float* cw = p.conv_w + l * 3 * 512 + lane * 8;
    const float* cb = p.conv_b + l * 512 + lane * 8;
    float y[8];
#pragma unroll
    for (int e = 0; e < 8; ++e) {
      float cv = cw[e] * gm[e] * um[e] + cw[512 + e] * g0[e] * u0[e] + cw[1024 + e] * gp[e] * up[e] + cb[e];
      y[e] = gb[e] * cv * siluf_(zb[e]);
    }
    *(u32x4*)(pr + C_YB + lane * 8) = PACK8(y);
  }
  *(u32x4*)(pr + C_KK + lane * 8) = kkp;
}
__device__ void phase_prep(const Params& p, int l, char* lds) {
  const int tid = opaque_tid(), lane = tid & 63, wid = tid >> 6;
  const int nspan = M / 136;
  for (int sp = blockIdx.x; sp < nspan; sp += gridDim.x) {
    const int row0 = sp * 136, b = row0 / S, s0 = row0 % S;
    for (int i = tid; i < 136 * 64; i += NTHR) {
      const int tok = i >> 6, ch = i & 63;
      *(u32x4*)(lds + tok * 1040 + ch * 16) = *(const u32x4*)(WS_PROJ(p) + (size_t)(row0 + tok) * NP + C_VD + ch * 8);
    }
    __syncthreads();
    for (int i = tid; i < 512 * 17; i += NTHR) {
      const int dv = i / 17, cch = i - dv * 17, head = dv >> 7, dvl = dv & 127;
      unsigned short e[8];
#pragma unroll
      for (int q = 0; q < 8; ++q) e[q] = *(const unsigned short*)(lds + (cch * 8 + q) * 1040 + dv * 2);
      u32x4 o = {(unsigned)e[0] | ((unsigned)e[1] << 16), (unsigned)e[2] | ((unsigned)e[3] << 16), (unsigned)e[4] | ((unsigned)e[5] << 16),
                 (unsigned)e[6] | ((unsigned)e[7] << 16)};
      *(u32x4*)(WS_VT(p) + ((size_t)(b * 4 + head) * 128 + dvl) * S + s0 + cch * 8) = o;
    }
    for (int i = 0; i < 17; ++i) prep_token(p, l, row0 + wid * 17 + i, lane);
    __syncthreads();
  }
}

constexpr int SC_CH = 32;
constexpr int SC_TS = 68, SC_VS = 36;
constexpr int SC_ARR = SC_CH * SC_TS * 4;
constexpr int SC_R = 0, SC_KK = SC_ARR, SC_W = 2 * SC_ARR, SC_KD = 3 * SC_ARR, SC_AK = 4 * SC_ARR, SC_V = 5 * SC_ARR, SC_BUF = 5 * SC_ARR + SC_CH * SC_VS * 4;
constexpr int SC_Y = 2 * SC_BUF;
constexpr int SC_WF = SC_Y + 8192;
__device__ __forceinline__ int scan_row(int b, int dir, int j) {
  const int s = dir == 0 ? j : (j < CTX ? (CTX - 1 - j) : (S + CTX - 1 - j));
  return b * S + s;
}
__device__ void phase_scan(const Params& p, int l, char* lds) {
  const int tid = opaque_tid(), lane = tid & 63, wid = tid >> 6, fr = lane & 15, fq = lane >> 4;
  for (int u = blockIdx.x; u < 256; u += gridDim.x) {
    const int pr_ = (u & 7) * 8 + (u >> 5), hd_ = (u >> 3) & 3;
    const int half = hd_ & 1, dir = hd_ >> 1, h = pr_ & 7, b = pr_ >> 3;
    const int c_lw = dir ? C_LWB : C_LWF, c_la = dir ? C_LAB : C_LAF, c_ys = dir ? C_YSB : C_YSF;
    if (wid == 4) {
      const float* du = p.decay_up + (size_t)(l * 2 + dir) * 64 * 512 + h * 64;
      const float* iu = p.iclr_up + (size_t)(l * 2 + dir) * 64 * 512 + h * 64;
#pragma unroll 1
      for (int f8 = 0; f8 < 8; ++f8) {
        const int nt = f8 >> 1, ks = f8 & 1;
        float fd[8], fi[8];
#pragma unroll
        for (int e = 0; e < 8; ++e) {
          const int k = ks * 32 + fq * 8 + e;
          fd[e] = du[(size_t)k * 512 + nt * 16 + fr];
          fi[e] = iu[(size_t)k * 512 + nt * 16 + fr];
        }
        *(u32x4*)(lds + SC_WF + (f8 * 64 + lane) * 16) = PACK8(fd);
        *(u32x4*)(lds + SC_WF + 8192 + (f8 * 64 + lane) * 16) = PACK8(fi);
      }
    }
    __syncthreads();
    const int pq = wid - 4, pth = pq & 1, pn0 = (pq >> 1) * 2, pti = pth * 16 + fr;
    bf16x8 P_tl[2], P_ta[2];
    u32x2 P_r[2], P_k[2], P_kk[2];
    u32x2 P_v;
    auto pload = [&](int c) {
      const bf16_t* pr = WS_PROJ(p) + (size_t)scan_row(b, dir, c * SC_CH + pti) * NP;
#pragma unroll
      for (int ks = 0; ks < 2; ++ks) {
        P_tl[ks] = *(const bf16x8*)(pr + c_lw + ks * 32 + fq * 8);
        P_ta[ks] = *(const bf16x8*)(pr + c_la + ks * 32 + fq * 8);
      }
#pragma unroll
      for (int n2 = 0; n2 < 2; ++n2) {
        const int gch = h * 64 + (pn0 + n2) * 16 + 4 * fq;
        P_r[n2] = *(const u32x2*)(pr + C_R + gch);
        P_k[n2] = *(const u32x2*)(pr + C_K + gch);
        P_kk[n2] = *(const u32x2*)(pr + C_KK + gch);
      }
      P_v = *(const u32x2*)(pr + C_V + h * 64 + half * 32 + (pq >> 1) * 16 + fq * 4);
    };
    f32x4 Cw0[2], Ca0[2], Cka[2];
    if (wid >= 4) {
#pragma unroll
      for (int n2 = 0; n2 < 2; ++n2) {
        const int gch = h * 64 + (pn0 + n2) * 16 + 4 * fq;
        Cw0[n2] = *(const f32x4*)(p.decay_w0 + (l * 2 + dir) * 512 + gch);
        Ca0[n2] = *(const f32x4*)(p.iclr_a0 + (l * 2 + dir) * 512 + gch);
        Cka[n2] = *(const f32x4*)(p.k_a + l * 512 + gch);
      }
    }
    auto pcompute = [&](int c) {
      char* buf = lds + (c & 1) * SC_BUF;
#pragma unroll
      for (int n2 = 0; n2 < 2; ++n2) {
        const int nt = pn0 + n2;
        f32x4 aw = {0.f, 0.f, 0.f, 0.f}, aa = {0.f, 0.f, 0.f, 0.f};
#pragma unroll
        for (int ks = 0; ks < 2; ++ks) {
          const bf16x8 wd = *(const bf16x8*)(lds + SC_WF + ((nt * 2 + ks) * 64 + lane) * 16);
          const bf16x8 wi = *(const bf16x8*)(lds + SC_WF + 8192 + ((nt * 2 + ks) * 64 + lane) * 16);
          aw = __builtin_amdgcn_mfma_f32_16x16x32_bf16(wd, P_tl[ks], aw, 0, 0, 0);
          aa = __builtin_amdgcn_mfma_f32_16x16x32_bf16(wi, P_ta[ks], aa, 0, 0, 0);
        }
        const int ch = nt * 16 + 4 * fq, gch = h * 64 + ch;
        const f32x4 w0 = Cw0[n2], a0 = Ca0[n2], ka = Cka[n2];
        const u32x2 r2 = P_r[n2], k2 = P_k[n2], kk2 = P_kk[n2];
        const f32x4 rv = {bf_lo(r2.x), bf_hi(r2.x), bf_lo(r2.y), bf_hi(r2.y)};
        const f32x4 kv = {bf_lo(k2.x), bf_hi(k2.x), bf_lo(k2.y), bf_hi(k2.y)};
        const f32x4 kkv = {bf_lo(kk2.x), bf_hi(kk2.x), bf_lo(kk2.y), bf_hi(kk2.y)};
        f32x4 wv, kd, ak;
#pragma unroll
        for (int j = 0; j < 4; ++j) {
          const float sg = sigmoidf_(aw[j] + w0[j]);
          wv[j] = __expf(-0.6065306597f * sg);
          const float a = sigmoidf_(aa[j] + a0[j]);
          kd[j] = kv[j] * (1.f + (a - 1.f) * ka[j]);
          ak[j] = a * kkv[j];
        }
        const int o = (pti * SC_TS + ch) * 4;
        *(f32x4*)(buf + SC_R + o) = rv;
        *(f32x4*)(buf + SC_KK + o) = kkv;
        *(f32x4*)(buf + SC_W + o) = wv;
        *(f32x4*)(buf + SC_KD + o) = kd;
        *(f32x4*)(buf + SC_AK + o) = ak;
      }
      *(f32x4*)(buf + SC_V + (pti * SC_VS + (pq >> 1) * 16 + fq * 4) * 4) = (f32x4){bf_lo(P_v.x), bf_hi(P_v.x), bf_lo(P_v.y), bf_hi(P_v.y)};
    };
    auto flush_y = [&](int c) {
      const int pt = tid - 256, tok = pt >> 3, r4 = (pt & 7) * 4;
      const f32x4 yv = *(const f32x4*)((const float*)(lds + SC_Y) + (c & 1) * 1024 + tok * 32 + r4);
      const int row = scan_row(b, dir, c * SC_CH + tok);
      const u32x2 o = {pack_bf16(yv.x, yv.y), pack_bf16(yv.z, yv.w)};
      *(u32x2*)(WS_PROJ(p) + (size_t)row * NP + c_ys + h * 64 + half * 32 + r4) = o;
    };
    const int nchunk = S / SC_CH;
    if (wid >= 4) { pload(0); pcompute(0); pload(1); }
    __syncthreads();
    f32x2 S2[4];
#pragma unroll
    for (int i = 0; i < 4; ++i) S2[i] = (f32x2){0.f, 0.f};
    const int rl = lane >> 3, cg8 = lane & 7;
    for (int c = 0; c < nchunk; ++c) {
      if (wid < 4) {
        const char* buf = lds + (c & 1) * SC_BUF;
        float* yb = (float*)(lds + SC_Y) + (c & 1) * 1024;
#define SC_LOAD(P, i_)                                                                                         \
  {                                                                                                            \
    const int o_ = ((i_) * SC_TS + cg8 * 8) * 4;                                                                  \
    P##ka = *(const f32x4*)(buf + SC_KK + o_); P##kb = *(const f32x4*)(buf + SC_KK + o_ + 16);                 \
    P##wa = *(const f32x4*)(buf + SC_W + o_);  P##wb = *(const f32x4*)(buf + SC_W + o_ + 16);                  \
    P##da = *(const f32x4*)(buf + SC_KD + o_); P##db = *(const f32x4*)(buf + SC_KD + o_ + 16);                 \
    P##aa = *(const f32x4*)(buf + SC_AK + o_); P##ab = *(const f32x4*)(buf + SC_AK + o_ + 16);                 \
    P##ra = *(const f32x4*)(buf + SC_R + o_);  P##rb = *(const f32x4*)(buf + SC_R + o_ + 16);                  \
    P##vv = *(const float*)(buf + SC_V + ((i_) * SC_VS + wid * 8 + rl) * 4);                                      \
  }
#define SC_STEP(P, i_)                                                                                         \
  {                                                                                                            \
    f32x2 d2 = S2[0] * (f32x2){P##ka.x, P##ka.y};                                                              \
    d2 = __builtin_elementwise_fma(S2[1], (f32x2){P##ka.z, P##ka.w}, d2);                                      \
    d2 = __builtin_elementwise_fma(S2[2], (f32x2){P##kb.x, P##kb.y}, d2);                                      \
    d2 = __builtin_elementwise_fma(S2[3], (f32x2){P##kb.z, P##kb.w}, d2);                                      \
      \
    float ra_ = d2.x + d2.y, rb_ = ypend;                                                                     \
    ra_ += dppf<0xB1>(ra_); rb_ += dppf<0xB1>(rb_);                                                            \
    ra_ += dppf<0x4E>(ra_); rb_ += dppf<0x4E>(rb_);                                                            \
    ra_ += dppf<0x141>(ra_); rb_ += dppf<0x141>(rb_);                                                          \
    yb[((i_) > 0 ? (i_) - 1 : 0) * 32 + wid * 8 + rl] = rb_;     \
    const float skk = ra_;                                                                                     \
    const f32x2 v2 = {P##vv, P##vv}, nk2 = {-skk, -skk};                                                       \
    f32x2 t0 = v2 * (f32x2){P##da.x, P##da.y}, t1 = v2 * (f32x2){P##da.z, P##da.w};                            \
    f32x2 t2 = v2 * (f32x2){P##db.x, P##db.y}, t3 = v2 * (f32x2){P##db.z, P##db.w};                            \
    t0 = __builtin_elementwise_fma(nk2, (f32x2){P##aa.x, P##aa.y}, t0);                                        \
    t1 = __builtin_elementwise_fma(nk2, (f32x2){P##aa.z, P##aa.w}, t1);                                        \
    t2 = __builtin_elementwise_fma(nk2, (f32x2){P##ab.x, P##ab.y}, t2);                                        \
    t3 = __builtin_elementwise_fma(nk2, (f32x2){P##ab.z, P##ab.w}, t3);                                        \
    S2[0] = __builtin_elementwise_fma(S2[0], (f32x2){P##wa.x, P##wa.y}, t0);                                   \
    S2[1] = __builtin_elementwise_fma(S2[1], (f32x2){P##wa.z, P##wa.w}, t1);                                   \
    S2[2] = __builtin_elementwise_fma(S2[2], (f32x2){P##wb.x, P##wb.y}, t2);                                   \
    S2[3] = __builtin_elementwise_fma(S2[3], (f32x2){P##wb.z, P##wb.w}, t3);                                   \
    f32x2 y2 = S2[0] * (f32x2){P##ra.x, P##ra.y};                                                              \
    y2 = __builtin_elementwise_fma(S2[1], (f32x2){P##ra.z, P##ra.w}, y2);                                      \
    y2 = __builtin_elementwise_fma(S2[2], (f32x2){P##rb.x, P##rb.y}, y2);                                      \
    y2 = __builtin_elementwise_fma(S2[3], (f32x2){P##rb.z, P##rb.w}, y2);                                      \
    ypend = y2.x + y2.y;                                         \
  }
        f32x4 Aka, Akb, Awa, Awb, Ada, Adb, Aaa, Aab, Ara, Arb, Bka, Bkb, Bwa, Bwb, Bda, Bdb, Baa, Bab, Bra, Brb;
        float Avv, Bvv, ypend = 0.f;
        SC_LOAD(A, 0);
#pragma unroll 1
        for (int i = 0; i < SC_CH; i += 2) {
          SC_LOAD(B, i + 1);
          SC_STEP(A, i);
          if (i + 2 < SC_CH) SC_LOAD(A, i + 2);
          SC_STEP(B, i + 1);
        }
        yb[(SC_CH - 1) * 32 + wid * 8 + rl] = allreduce8(ypend);
      } else {
        if (c + 1 < nchunk) pcompute(c + 1);
        if (c + 2 < nchunk) pload(c + 2);
        if (c > 0) flush_y(c - 1);
      }
      __syncthreads();
    }
    if (wid >= 4) flush_y(nchunk - 1);
    __syncthreads();
  }
}

constexpr int A_STAGE = 35840, A_VOFF = 17408, A_VSTR = 136;
__device__ void attn_unit(const Params& p, int l, int b, int head, int q0, int nkt, float lam, float lam_init, float bound2, char* lds) {
  int lane = __builtin_amdgcn_mbcnt_hi(~0u, __builtin_amdgcn_mbcnt_lo(~0u, 0u));
  asm volatile("" : "+v"(lane));
  const int wid = __builtin_amdgcn_readfirstlane(threadIdx.x >> 6), tid = wid * 64 + lane, fr = lane & 15, fq = lane >> 4;
  const int qrow = b * S + q0 + wid * 16 + fr;
  bf16x8 qf[2][2];
#pragma unroll
  for (int c = 0; c < 2; ++c)
#pragma unroll
    for (int ks = 0; ks < 2; ++ks) qf[c][ks] = *(const bf16x8*)(WS_PROJ(p) + (size_t)qrow * NP + C_QD + head * 128 + c * 64 + ks * 32 + fq * 8);
  f32x4 O[2][8];
  float ls[2] = {0.f, 0.f};
#pragma unroll
  for (int c = 0; c < 2; ++c)
#pragma unroll
    for (int dt = 0; dt < 8; ++dt) O[c][dt] = (f32x4){0.f, 0.f, 0.f, 0.f};
  const bf16_t* kg = WS_PROJ(p) + (size_t)(b * S + (tid >> 4)) * NP + C_KD + head * 128 + (tid & 15) * 8;
  const bf16_t* vg = WS_VT(p) + ((size_t)(b * 4 + head) * 128 + (tid >> 3)) * S + (tid & 7) * 8;
  const int ksto = (tid >> 4) * 272 + (tid & 15) * 16, vsto = A_VOFF + (tid >> 3) * A_VSTR + (tid & 7) * 16;
  u32x4 rk[2], rv[2];
#pragma unroll
  for (int i = 0; i < 2; ++i) {
    rk[i] = *(const u32x4*)(kg + (size_t)(32 * i) * NP);
    rv[i] = *(const u32x4*)(vg + (size_t)(64 * i) * S);
  }
#pragma unroll
  for (int i = 0; i < 2; ++i) {
    *(u32x4*)(lds + ksto + i * 32 * 272) = rk[i];
    *(u32x2*)(lds + vsto + i * 64 * A_VSTR) = (u32x2){rv[i].x, rv[i].y};
    *(u32x2*)(lds + vsto + i * 64 * A_VSTR + 8) = (u32x2){rv[i].z, rv[i].w};
  }
  __syncthreads();
  for (int kt = 0; kt < nkt; ++kt) {
    const char* base = lds + (kt & 1) * A_STAGE;
    const bool more = kt + 1 < nkt;
    if (more) {
#pragma unroll
      for (int i = 0; i < 2; ++i) {
        rk[i] = *(const u32x4*)(kg + (size_t)((kt + 1) * 64 + 32 * i) * NP);
        rv[i] = *(const u32x4*)(vg + (size_t)(64 * i) * S + (kt + 1) * 64);
      }
    }
#pragma unroll
    for (int g = 0; g < 2; ++g) {
      bf16x8 pf[2];
#pragma unroll
      for (int c = 0; c < 2; ++c) {
        f32x4 sa[2];
        sa[0] = (f32x4){-bound2, -bound2, -bound2, -bound2};
        sa[1] = sa[0];
#pragma unroll
        for (int ks = 0; ks < 2; ++ks)
#pragma unroll
          for (int k2 = 0; k2 < 2; ++k2) {
            const bf16x8 kf = *(const bf16x8*)(base + ((g * 2 + k2) * 16 + fr) * 272 + (c * 64 + ks * 32 + fq * 8) * 2);
            sa[k2] = __builtin_amdgcn_mfma_f32_16x16x32_bf16(kf, qf[c][ks], sa[k2], 0, 0, 0);
          }
        float acc_l = 0.f;
#pragma unroll
        for (int k2 = 0; k2 < 2; ++k2)
#pragma unroll
          for (int j = 0; j < 4; ++j) {
            const float pe = __builtin_amdgcn_exp2f(sa[k2][j]);
            sa[k2][j] = pe;
            acc_l += pe;
          }
        ls[c] += acc_l;
        u32x4 pk = {pack_bf16_b(sa[0][0], sa[0][1]), pack_bf16_b(sa[0][2], sa[0][3]), pack_bf16_b(sa[1][0], sa[1][1]), pack_bf16_b(sa[1][2], sa[1][3])};
        pf[c] = __builtin_bit_cast(bf16x8, pk);
      }
#pragma unroll
      for (int dt = 0; dt < 8; ++dt) {
        const u32x2 v0 = *(const u32x2*)(base + A_VOFF + (dt * 16 + fr) * A_VSTR + (g * 32 + 4 * fq) * 2);
        const u32x2 v1 = *(const u32x2*)(base + A_VOFF + (dt * 16 + fr) * A_VSTR + (g * 32 + 16 + 4 * fq) * 2);
        const u32x4 vv = {v0.x, v0.y, v1.x, v1.y};
        const bf16x8 vf = __builtin_bit_cast(bf16x8, vv);
        O[0][dt] = __builtin_amdgcn_mfma_f32_16x16x32_bf16(vf, pf[0], O[0][dt], 0, 0, 0);
        O[1][dt] = __builtin_amdgcn_mfma_f32_16x16x32_bf16(vf, pf[1], O[1][dt], 0, 0, 0);
      }
    }
    if (more) {
      char* nb = lds + ((kt + 1) & 1) * A_STAGE;
#pragma unroll
      for (int i = 0; i < 2; ++i) {
        *(u32x4*)(nb + ksto + i * 32 * 272) = rk[i];
        *(u32x2*)(nb + vsto + i * 64 * A_VSTR) = (u32x2){rv[i].x, rv[i].y};
        *(u32x2*)(nb + vsto + i * 64 * A_VSTR + 8) = (u32x2){rv[i].z, rv[i].w};
      }
    }
    __syncthreads();
  }
  float l0 = ls[0], l1 = ls[1];
  l0 += shflx(l0, 16, lane); l0 += shflx(l0, 32, lane);
  l1 += shflx(l1, 16, lane); l1 += shflx(l1, 32, lane);
  const float i0 = 1.f / l0, i1 = lam / l1;
  float ss = 0.f;
#pragma unroll
  for (int dt = 0; dt < 8; ++dt) {
    f32x4 o = O[0][dt] * i0 - O[1][dt] * i1;
    O[0][dt] = o;
    ss += o.x * o.x + o.y * o.y + o.z * o.z + o.w * o.w;
  }
  ss += shflx(ss, 16, lane); ss += shflx(ss, 32, lane);
  const float rn = rsqrtf(ss * (1.f / 128.f) + 1e-6f) * (1.f - lam_init);
  bf16_t* pr = WS_PROJ(p) + (size_t)qrow * NP + head * 128 + 4 * fq;
  const float* sg = p.subln_g + l * 128 + 4 * fq;
#pragma unroll
  for (int dt = 0; dt < 8; ++dt) {
    const int dv = dt * 16;
    const u32x2 z2 = *(const u32x2*)(pr + C_ZC + dv);
    const f32x4 g4 = *(const f32x4*)(sg + dv);
    const f32x4 o = O[0][dt];
    const float y0 = o.x * rn * g4.x * siluf_(bf_lo(z2.x)), y1 = o.y * rn * g4.y * siluf_(bf_hi(z2.x));
    const float y2 = o.z * rn * g4.z * siluf_(bf_lo(z2.y)), y3 = o.w * rn * g4.w * siluf_(bf_hi(z2.y));
    u32x2 ov = {pack_bf16(y0, y1), pack_bf16(y2, y3)};
    *(u32x2*)(pr + C_YC + dv) = ov;
  }
}
__device__ __forceinline__ void rwkv_out_token(const Params& p, int l, int row, int lane) {
  bf16_t* pr = WS_PROJ(p) + (size_t)row * NP;
  float yf[8], yb[8], r[8], k[8], v[8], z[8];
  u32x4 raw;
  raw = *(const u32x4*)(pr + C_YSF + lane * 8); UNPACK8(raw, yf);
  raw = *(const u32x4*)(pr + C_YSB + lane * 8); UNPACK8(raw, yb);
  raw = *(const u32x4*)(pr + C_R + lane * 8); UNPACK8(raw, r);
  raw = *(const u32x4*)(pr + C_K + lane * 8); UNPACK8(raw, k);
  raw = *(const u32x4*)(pr + C_V + lane * 8); UNPACK8(raw, v);
  raw = *(const u32x4*)(pr + C_ZA + lane * 8); UNPACK8(raw, z);
  const float* rk = p.r_k + l * 512 + lane * 8;
  const float* gg = p.gn_g + l * 512 + lane * 8;
  const float* gb = p.gn_b + l * 512 + lane * 8;
  float sm = 0.f, bs = 0.f;
#pragma unroll
  for (int e = 0; e < 8; ++e) { yf[e] += yb[e]; sm += yf[e]; bs += r[e] * k[e] * rk[e]; }
  sm = grp8_sum(sm); bs = grp8_sum(bs);
  const float mu = sm * (1.f / 64.f);
  float vs = 0.f;
#pragma unroll
  for (int e = 0; e < 8; ++e) { yf[e] -= mu; vs += yf[e] * yf[e]; }
  vs = grp8_sum(vs);
  const float rs = rsqrtf(vs * (1.f / 64.f) + 64e-5f);
  float o[8];
#pragma unroll
  for (int e = 0; e < 8; ++e) o[e] = (yf[e] * rs * gg[e] + gb[e] + bs * v[e]) * siluf_(z[e]);
  *(u32x4*)(pr + C_YA + lane * 8) = PACK8(o);
}
__device__ void phase_attn(const Params& p, int l, char* lds) {
  const int tid0 = opaque_tid();
  const int lane = tid0 & 63;
  const float lam_init = __int_as_float(__builtin_amdgcn_readfirstlane(__float_as_int(0.8f - 0.6f * __expf(-0.3f * (float)l))));
  const float* lq = p.lambda_qk + l * 256;
  float a1 = lq[lane] * lq[64 + lane], a2 = lq[128 + lane] * lq[192 + lane];
  a1 = wave_sum(a1); a2 = wave_sum(a2);
  const float lam = __int_as_float(__builtin_amdgcn_readfirstlane(__float_as_int(__expf(a1) - __expf(a2) + lam_init)));
  const float* qg = p.qk_norm_g + l * 128;
  float mq = fabsf(qg[lane]), mk = fabsf(qg[64 + lane]);
  mq = wave_max(mq); mk = wave_max(mk);
  const float bound2 = __int_as_float(__builtin_amdgcn_readfirstlane(__float_as_int(8.f * mq * mk * 1.44269504f * 1.02f + 0.1f)));
  const int nunit = (l < NL - 1) ? 1088 : 1024;
  for (int u = blockIdx.x; u < nunit; u += gridDim.x) {
    int b, head, q0, nkt;
    if (u < 1024) {
      const int xcd = u & 7, j = u >> 3, pair = xcd + 8 * (j >> 5), qb = j & 31;
      head = pair & 3; b = pair >> 2; q0 = CTX + qb * 128; nkt = S / 64;
    } else {
      const int v = u - 1024; head = (v >> 1) & 3; b = v >> 3; q0 = (v & 1) * 128; nkt = CTX / 64;
    }
    attn_unit(p, l, b, head, q0, nkt, lam, lam_init, bound2, lds);
  }
  const int tid1 = opaque_tid();
  const int gw = blockIdx.x * 8 + (tid1 >> 6), nw = gridDim.x * 8;
  for (int row = gw; row < M; row += nw) rwkv_out_token(p, l, row, tid1 & 63);
}

__device__ void phase_merge1(const Params& p, int l, char* lds) {
  const int tid = opaque_tid(), lane = tid & 63, wid = tid >> 6, wm = wid >> 1, wn = wid & 1, fr = lane & 15, fq = lane >> 4;
  const int xcd = blockIdx.x & 7, bi = blockIdx.x >> 3, nbx = (gridDim.x + 7 - xcd) >> 3;
  for (int idx = bi; idx < 17 * 8; idx += nbx) {
    const int mt = 17 * xcd + (idx >> 3), nt = idx & 7;
    if (l == NL - 1 && (mt % 17) == 0) continue;
    u32x2 macc[4][4];
#pragma unroll
    for (int mi = 0; mi < 4; ++mi)
#pragma unroll
      for (int ni = 0; ni < 4; ++ni) macc[mi][ni] = (u32x2){0u, 0u};
#pragma unroll 1
    for (int i = 0; i < 3; ++i) {
      const int ycol = i == 0 ? C_YA : (i == 1 ? C_YB : C_YC);
      f32x4 acc[4][4];
#pragma unroll
      for (int mi = 0; mi < 4; ++mi)
#pragma unroll
        for (int ni = 0; ni < 4; ++ni) acc[mi][ni] = (f32x4){0.f, 0.f, 0.f, 0.f};
      gemm_256x128_dma(WS_PROJ(p) + (size_t)mt * 256 * NP + ycol, NP, WS_WB(p) + (size_t)(l & 1) * WSET + ((size_t)i * D + nt * 128) * 512, 512, 512, acc, lds, tid);
      u32x2 br[4][4];
#pragma unroll
      for (int mi = 0; mi < 4; ++mi)
#pragma unroll
        for (int ni = 0; ni < 4; ++ni) {
          const f32x4 av = mfma_guard(acc[mi][ni]);
          br[mi][ni] = (u32x2){pack_bf16(av.x, av.y), pack_bf16(av.z, av.w)};
          acc[mi][ni] = (f32x4){0.f, 0.f, 0.f, 0.f};
        }
      gemm_256x128_dma(WS_H(p) + (size_t)mt * 256 * D, D, WS_WG(p) + (size_t)(l & 1) * WSET + ((size_t)i * D + nt * 128) * D, D, D, acc, lds, tid);
#pragma unroll
      for (int mi = 0; mi < 4; ++mi)
#pragma unroll
        for (int ni = 0; ni < 4; ++ni) {
          const f32x4 a = acc[mi][ni];
          const u32x2 bb = br[mi][ni], mm = macc[mi][ni];
          const float m0 = bf_lo(mm.x) + sigmoidf_(a.x) * bf_lo(bb.x), m1 = bf_hi(mm.x) + sigmoidf_(a.y) * bf_hi(bb.x);
          const float m2 = bf_lo(mm.y) + sigmoidf_(a.z) * bf_lo(bb.y), m3 = bf_hi(mm.y) + sigmoidf_(a.w) * bf_hi(bb.y);
          macc[mi][ni] = (u32x2){pack_bf16(m0, m1), pack_bf16(m2, m3)};
        }
    }
#pragma unroll
    for (int mi = 0; mi < 4; ++mi) {
      const int row = mt * 256 + wm * 64 + mi * 16 + fr;
#pragma unroll
      for (int ni = 0; ni < 4; ++ni) {
        const int col = nt * 128 + wn * 64 + ni * 16 + 4 * fq;
        *(u32x2*)(WS_PROJ(p) + (size_t)row * NP + ((nt < 4) ? C_M0 : (C_M1 - 512)) + col) = macc[mi][ni];
      }
    }
  }
}

__device__ void phase_merge2(const Params& p, int l, char* lds) {
  const int tid = opaque_tid(), lane = tid & 63, wid = tid >> 6, wm = wid >> 1, wn = wid & 1, fr = lane & 15, fq = lane >> 4;
  const int xcd = blockIdx.x & 7, bi = blockIdx.x >> 3, nbx = (gridDim.x + 7 - xcd) >> 3;
  for (int idx = bi; idx < 17 * 8; idx += nbx) {
    const int mt = 17 * xcd + (idx >> 3), nt = idx & 7;
    const bool isctx = (mt % 17) == 0;
    if (l == NL - 1 && isctx) continue;
    f32x4 acc[4][4];
#pragma unroll
    for (int mi = 0; mi < 4; ++mi)
#pragma unroll
      for (int ni = 0; ni < 4; ++ni) acc[mi][ni] = (f32x4){0.f, 0.f, 0.f, 0.f};
    gemm_256x128_dma(WS_PROJ(p) + (size_t)mt * 256 * NP + C_M0, NP, WS_WO(p) + (size_t)(l & 1) * WSET + (size_t)nt * 128 * D, D, D, acc, lds, tid, 8,
                     (C_M1 - C_M0 - 512) * 2);
    const int b = mt / 17;
    const float* gate = WS_MOD(p) + ((size_t)l * 9 + (isctx ? 8 : b)) * 3072 + 2048;
#pragma unroll
    for (int mi = 0; mi < 4; ++mi) {
      const int row = mt * 256 + wm * 64 + mi * 16 + fr, s = row - b * S;
      const float* xs = xrow_src(p, l, b, s);
      float* xd = isctx ? (WS_CTXS(p) + ((size_t)b * CTX + s) * D) : (p.out + ((size_t)b * T + (s - CTX)) * D);
#pragma unroll
      for (int ni = 0; ni < 4; ++ni) {
        const int col = nt * 128 + wn * 64 + ni * 16 + 4 * fq;
        const f32x4 g = *(const f32x4*)(gate + col);
        const f32x4 xv = *(const f32x4*)(xs + col);
        *(f32x4*)(xd + col) = xv + g * acc[mi][ni];
      }
    }
  }
}

#ifndef MULTI_LAUNCH
#define MULTI_LAUNCH 0
#endif
#ifndef DUMP_STAGE
#define DUMP_STAGE 0
#define NL_RUN 4
#define PROBE_MEMSET 1
#endif
#if !MULTI_LAUNCH && !DUMP_STAGE
__device__ __forceinline__ void l2_refresh(const Params& p, unsigned seq) {
  const float* base = (seq & 1u) ? p.x : p.w_in;
  const f32x4* src = (const f32x4*)(base + (size_t)blockIdx.x * 131072) + threadIdx.x;
  f32x4 a = {0.f, 0.f, 0.f, 0.f};
  f32x4 a1 = a, a2 = a, a3 = a;
#pragma unroll 1
  for (int i = 0; i < 64; i += 16) {
    f32x4 t[16];
#pragma unroll
    for (int j = 0; j < 16; ++j) t[j] = src[(i + j) * NTHR];
#pragma unroll
    for (int j = 0; j < 16; j += 4) { a += t[j]; a1 += t[j + 1]; a2 += t[j + 2]; a3 += t[j + 3]; }
  }
  a += a1 + a2 + a3;
  asm volatile("" ::"v"(a.x), "v"(a.y), "v"(a.z), "v"(a.w));
}

__device__ __forceinline__ void grid_barrier(unsigned* bar, unsigned target) {
  asm volatile("s_waitcnt vmcnt(0) lgkmcnt(0)" ::: "memory");
  __syncthreads();
  if (threadIdx.x == 0) {
    __builtin_amdgcn_fence(__ATOMIC_RELEASE, "");
    asm volatile("s_waitcnt vmcnt(0)" ::: "memory");
    __hip_atomic_fetch_add(bar, 1u, __ATOMIC_RELAXED, __HIP_MEMORY_SCOPE_AGENT);
    while ((int)(__hip_atomic_load(bar, __ATOMIC_RELAXED, __HIP_MEMORY_SCOPE_AGENT) - target) < 0) __builtin_amdgcn_s_sleep(2);
    __builtin_amdgcn_fence(__ATOMIC_ACQUIRE, "");
    asm volatile("s_waitcnt vmcnt(0)" ::: "memory");
  }
  __syncthreads();
}

__device__ void phase_dump(const Params& p, int what) {
  const size_t n = (size_t)NB * T * D;
  for (size_t i = blockIdx.x * (size_t)NTHR + threadIdx.x; i < n; i += (size_t)gridDim.x * NTHR) {
    float v = 0.f;
    if (what == 1) { const int rr = (int)(i / D) % S; v = bf_lo(WS_H(p)[i]); (void)rr; }
    else if (what == 7) v = bf_lo(WS_WG(p)[i % ((size_t)3072 * D)]) + bf_lo(WS_WB(p)[i % ((size_t)1536 * D)]) + bf_lo(WS_WO(p)[i % ((size_t)D * D)]);
    else if (what == 6) { const unsigned* q = (const unsigned*)(WS_PROJ(p) + i * 6);
      for (int j = 0; j < 3; ++j) { unsigned w = __hip_atomic_load(q + j, __ATOMIC_RELAXED, __HIP_MEMORY_SCOPE_AGENT); v += bf_lo(w) + bf_hi(w); } }
    else { for (int j = 0; j < 6; ++j) v += bf_lo(WS_PROJ(p)[i * 6 + j]); if (what == 3) v += bf_lo(WS_VT(p)[i % ((size_t)NB * 4 * 128 * S)]); }
    p.out[i] = v;
  }
}
#ifndef PROBE_TWICE
#define PROBE_TWICE 0
#endif
#ifndef MK_DUMP
#define MK_DUMP 0
#define MK_DUMP_L 0
#endif
__global__ void __launch_bounds__(NTHR) fwd_megakernel(Params p, int l0, int l1) {
  __shared__ __attribute__((aligned(16))) char lds[LDS_BYTES];
  cg::grid_group grid = cg::this_grid();
  unsigned nbar = __builtin_amdgcn_readfirstlane(__hip_atomic_load(WS_BAR(p), __ATOMIC_RELAXED, __HIP_MEMORY_SCOPE_AGENT));
  grid.sync();
  const unsigned nblk = gridDim.x;
#define NL_MK 2
  unsigned nflush = 0;
#define GSYNC() do { nbar += nblk; grid_barrier(WS_BAR(p), nbar); } while (0)
#define GSYNC_REFRESH() do { nbar += nblk; grid_barrier(WS_BAR(p), nbar); l2_refresh(p, nflush++); nbar += nblk; grid_barrier(WS_BAR(p), nbar); } while (0)
  if (l0 == 0) { phase_mod(p, lds); GSYNC(); }
  for (int l = l0; l < l1; ++l) {
    if (MK_DUMP == 8 && l == MK_DUMP_L) return;
    phase_norm(p, l);
    if (l == l0) phase_cvt(p, l, lds, blockIdx.x, gridDim.x);
    GSYNC();
    if (MK_DUMP == 1 && l == MK_DUMP_L) { phase_dump(p, 1); return; }
    if (MK_DUMP == 7 && l == MK_DUMP_L) { phase_dump(p, 7); return; }
    phase_inproj(p, l, lds);
#if PROBE_TWICE == 1
    GSYNC(); phase_inproj(p, l, lds);
#endif
    GSYNC();
    if (MK_DUMP == 2 && l == MK_DUMP_L) { phase_dump(p, 2); return; }
    phase_prep(p, l, lds);
    GSYNC();
    if (MK_DUMP == 3 && l == MK_DUMP_L) { phase_dump(p, 3); return; }
    phase_scan(p, l, lds);
#if PROBE_TWICE == 2
    GSYNC(); phase_scan(p, l, lds);
#endif
    GSYNC_REFRESH();
    if (MK_DUMP == 4 && l == MK_DUMP_L) { phase_dump(p, 4); return; }
    phase_attn(p, l, lds);
    GSYNC();
    if (MK_DUMP == 5 && l == MK_DUMP_L) { phase_dump(p, 5); return; }
    phase_merge1(p, l, lds);
#if PROBE_TWICE == 3
    GSYNC(); phase_merge1(p, l, lds);
#endif
    GSYNC();
    if (MK_DUMP == 6 && l == MK_DUMP_L) { phase_dump(p, 6); return; }
    phase_merge2(p, l, lds);
    if (l + 1 < l1) {
      if (gridDim.x == 256) { const int bi = blockIdx.x >> 3; if (bi >= 8) phase_cvt(p, l + 1, lds, (bi - 8) * 8 + (blockIdx.x & 7), 192); }
      else phase_cvt(p, l + 1, lds, blockIdx.x, gridDim.x);
    }
    if (l + 1 < l1) GSYNC_REFRESH();
  }
}
#endif
#if MULTI_LAUNCH || DUMP_STAGE
__global__ void __launch_bounds__(NTHR) phase_kernel(Params p, int phase, int l) {
  __shared__ __attribute__((aligned(16))) char lds[LDS_BYTES];
  switch (phase) {
    case 0: phase_mod(p, lds); break;
    case 1: phase_norm(p, l); phase_cvt(p, l, lds, blockIdx.x, gridDim.x); break;
    case 2: phase_inproj(p, l, lds); break;
    case 3: phase_prep(p, l, lds); break;
    case 4: phase_scan(p, l, lds); break;
    case 5: phase_attn(p, l, lds); break;
    case 6: phase_merge1(p, l, lds); break;
    default: phase_merge2(p, l, lds); break;
  }
}

__global__ void dump_kernel(Params p, int stage, int n) {
  for (size_t i = blockIdx.x * (size_t)blockDim.x + threadIdx.x; i < (size_t)n; i += (size_t)gridDim.x * blockDim.x) {
    float v = 0.f;
    if (stage == 1) v = WS_MOD(p)[i % (NL * 9 * 3072)];
    else if (stage == 2) v = bf_lo(WS_H(p)[i]);
    else if (stage == 3) v = bf_lo(WS_WIN(p)[i % ((size_t)NP * D)]) + bf_lo(WS_WG(p)[i % ((size_t)3072 * D)]) + bf_lo(WS_WB(p)[i % ((size_t)1536 * D)]) + bf_lo(WS_WO(p)[i % ((size_t)D * D)]);
    else if (stage == 4 || stage == 5) { for (int j = 0; j < 6; ++j) v += bf_lo(WS_PROJ(p)[i * 6 + j]); if (stage == 5) v += bf_lo(WS_VT(p)[i % ((size_t)NB * 4 * 128 * S)]); }
    p.out[i] = v;
  }
}
#endif

extern "C" void kernel_launch(void* const* d_in, const int* in_sizes, int n_in, void* d_out, int out_size, void* d_ws, size_t ws_size,
                              hipStream_t stream) {
  static int grid_blocks = 0;
#if !MULTI_LAUNCH && !DUMP_STAGE
  if (!grid_blocks) {
    int dev = 0, cus = 0, per_cu = 0;
    hipGetDevice(&dev);
    hipDeviceGetAttribute(&cus, hipDeviceAttributeMultiprocessorCount, dev);
    hipOccupancyMaxActiveBlocksPerMultiprocessor(&per_cu, fwd_megakernel, NTHR, 0);
    if (per_cu < 1) per_cu = 1;
    grid_blocks = cus * per_cu;
  }
#endif
  Params p{};
  const float** f = (const float**)&p;
  for (int i = 0; i < 24; ++i) f[i] = (const float*)d_in[i];
  p.out = (float*)d_out;
  p.ws = (char*)d_ws;
  const size_t off = WS_TOTAL;
  if (off > ws_size) { fprintf(stderr, "workspace too small: need %zu have %zu\n", off, ws_size); return; }
  hipMemsetAsync(WS_BAR(p), 0, 256, stream);
#if DUMP_STAGE
  {
    const int maxph = DUMP_STAGE == 1 ? 0 : (DUMP_STAGE <= 3 ? 1 : (DUMP_STAGE == 4 ? 2 : 3));
    for (int ph = 0; ph <= maxph; ++ph) phase_kernel<<<dim3(256), dim3(NTHR), 0, stream>>>(p, ph, 0);
    dump_kernel<<<dim3(1024), dim3(256), 0, stream>>>(p, DUMP_STAGE, out_size);
    return;
  }
#endif
#if MULTI_LAUNCH
  phase_kernel<<<dim3(256), dim3(NTHR), 0, stream>>>(p, 0, 0);
  for (int l = 0; l < NL_RUN; ++l)
    for (int ph = 1; ph <= 7; ++ph) {
#ifdef SKIP_SCAN
      if (ph == 4) continue;
#endif
#ifdef SKIP_ATTN
      if (ph == 5) continue;
#endif
      phase_kernel<<<dim3(256), dim3(NTHR), 0, stream>>>(p, ph, l);
    }
  return;
#endif
#if !MULTI_LAUNCH && !DUMP_STAGE
#ifndef LAYERS_PER_LAUNCH
#define LAYERS_PER_LAUNCH 4
#endif
  for (int l0 = 0; l0 < (MK_DUMP ? MK_DUMP_L + 1 : NL); l0 += LAYERS_PER_LAUNCH) {
    int a0 = l0, a1 = l0 + LAYERS_PER_LAUNCH;
    void* args[] = {&p, &a0, &a1};
    hipError_t e = hipLaunchCooperativeKernel((void*)fwd_megakernel, dim3(grid_blocks), dim3(NTHR), args, 0, stream);
    if (e != hipSuccess) fprintf(stderr, "cooperative launch failed: %s (grid %d)\n", hipGetErrorString(e), grid_blocks);
  }
#endif
}
```

```cpp
#include <hip/hip_runtime.h>
#include <hip/hip_cooperative_groups.h>
#include <cstdio>
#include <cstdint>
namespace cg = cooperative_groups;

typedef unsigned short bf16_t;
typedef short bf16x8 __attribute__((ext_vector_type(8)));
typedef float f32x4 __attribute__((ext_vector_type(4)));
typedef float f32x2 __attribute__((ext_vector_type(2)));
typedef unsigned u32x4 __attribute__((ext_vector_type(4)));
typedef unsigned u32x2 __attribute__((ext_vector_type(2)));

constexpr int D = 1024, NB = 8, T = 4096, NL = 4, CTX = 256, S = T + CTX, M = NB * S, NP = 6400, NIN = 9472;
constexpr int C_R = 0, C_K = 512, C_V = 1024, C_LWF = 1536, C_LWB = 1600, C_LAF = 1664, C_LAB = 1728, C_ZA = 1792,
              C_GB = 2304, C_GC = 2816, C_U = 3328, C_ZB = 3840, C_QD = 4352, C_KD = 4864, C_VD = 5376, C_ZC = 5888;
constexpr int C_YA = C_R, C_YB = C_GB, C_YC = C_QD, C_M0 = C_ZB, C_M1 = C_VD, C_YSF = C_GC, C_YSB = C_U, C_KK = C_ZB;
constexpr int NTHR = 512;
constexpr size_t WSET = (size_t)NP * D + (size_t)3072 * D + (size_t)3 * D * 512 + (size_t)D * D;
constexpr int LDS_BYTES = 147456;

struct Params {
  const float *x, *c, *ctx, *c_ctx, *w_mod, *b_mod, *norm_g, *w_in, *decay_w0, *decay_up, *iclr_a0, *iclr_up, *k_k, *k_a, *r_k,
      *gn_g, *gn_b, *conv_w, *conv_b, *qk_norm_g, *lambda_qk, *subln_g, *w_branch, *w_out;
  float* out;
  char* ws;
};
constexpr size_t al256(size_t x) { return (x + 255) & ~(size_t)255; }
constexpr size_t WSET_C = (size_t)NP * D + (size_t)3072 * D + (size_t)3 * D * 512 + (size_t)D * D;
constexpr size_t OFF_PROJ = 0;
constexpr size_t OFF_H = OFF_PROJ + al256((size_t)M * NP * 2);
constexpr size_t OFF_VT = OFF_H + al256((size_t)M * D * 2);
constexpr size_t OFF_W = OFF_VT + al256((size_t)NB * 4 * 128 * S * 2);
constexpr size_t OFF_CTXS = OFF_W + al256(2 * WSET_C * 2);
constexpr size_t OFF_MOD = OFF_CTXS + al256((size_t)NB * CTX * D * 4);
constexpr size_t OFF_BAR = OFF_MOD + al256((size_t)NL * 9 * 3072 * 4);
constexpr size_t WS_TOTAL = OFF_BAR + 256;
#define WS_PROJ(p) ((bf16_t*)((p).ws + OFF_PROJ))
#define WS_H(p) ((bf16_t*)((p).ws + OFF_H))
#define WS_VT(p) ((bf16_t*)((p).ws + OFF_VT))
#define WS_WIN(p) ((bf16_t*)((p).ws + OFF_W))
#define WS_WG(p) (WS_WIN(p) + (size_t)NP * D)
#define WS_WB(p) (WS_WG(p) + (size_t)3072 * D)
#define WS_WO(p) (WS_WB(p) + (size_t)3 * D * 512)
#define WS_CTXS(p) ((float*)((p).ws + OFF_CTXS))
#define WS_MOD(p) ((float*)((p).ws + OFF_MOD))
#define WS_BAR(p) ((unsigned*)((p).ws + OFF_BAR))

__device__ __forceinline__ int opaque_tid() { int t = threadIdx.x; asm volatile("" : "+v"(t)); return t; }
__device__ __forceinline__ float bf_lo(unsigned u) { return __uint_as_float(u << 16); }
__device__ __forceinline__ float bf_hi(unsigned u) { return __uint_as_float(u & 0xffff0000u); }
__device__ __forceinline__ unsigned pack_bf16(float lo, float hi) {
  unsigned r;
  asm("s_nop 0\n\tv_cvt_pk_bf16_f32 %0, %1, %2" : "=v"(r) : "v"(lo), "v"(hi));
  return r;
}
__device__ __forceinline__ float vmul_(float a, float b) { float d; asm("v_mul_f32 %0, %1, %2" : "=v"(d) : "v"(a), "v"(b)); return d; }
__device__ __forceinline__ float vfma_(float a, float b, float c) { float d; asm("v_fma_f32 %0, %1, %2, %3" : "=v"(d) : "v"(a), "v"(b), "v"(c)); return d; }
__device__ __forceinline__ float vfnma_(float a, float b, float c) { float d; asm("v_fma_f32 %0, -%1, %2, %3" : "=v"(d) : "v"(a), "v"(b), "v"(c)); return d; }
typedef __bf16 bf16v2_t __attribute__((ext_vector_type(2)));
__device__ __forceinline__ unsigned pack_bf16_b(float lo, float hi) {
  const f32x2 v = {lo, hi};
  return __builtin_bit_cast(unsigned, __builtin_convertvector(v, bf16v2_t));
}
__device__ __forceinline__ f32x4 mfma_guard(f32x4 v) { return v + (f32x4){0.f, 0.f, 0.f, 0.f}; }
__device__ __forceinline__ float sigmoidf_(float x) { return __builtin_amdgcn_rcpf(1.f + __expf(-x)); }
__device__ __forceinline__ float siluf_(float x) { return x * sigmoidf_(x); }
__device__ __forceinline__ float tanhf_(float x) { return 1.f - 2.f * __builtin_amdgcn_rcpf(__expf(2.f * x) + 1.f); }
template <int CTRL> __device__ __forceinline__ float dppf(float x) {
  return __int_as_float(__builtin_amdgcn_update_dpp(0, __float_as_int(x), CTRL, 0xF, 0xF, true));
}
__device__ __forceinline__ float allreduce8(float x) {
  x += dppf<0xB1>(x);
  x += dppf<0x4E>(x);
  x += dppf<0x141>(x);
  return x;
}
__device__ __forceinline__ float grp8_sum(float v) { return allreduce8(v); }
__device__ __forceinline__ float wave_sum(float v) {
  v = allreduce8(v);
  v += dppf<0x140>(v);
  return __int_as_float(__builtin_amdgcn_readlane(__float_as_int(v), 0)) + __int_as_float(__builtin_amdgcn_readlane(__float_as_int(v), 16)) +
         __int_as_float(__builtin_amdgcn_readlane(__float_as_int(v), 32)) + __int_as_float(__builtin_amdgcn_readlane(__float_as_int(v), 48));
}
__device__ __forceinline__ float wave_max(float v) {
  v = fmaxf(v, dppf<0xB1>(v));
  v = fmaxf(v, dppf<0x4E>(v));
  v = fmaxf(v, dppf<0x141>(v));
  v = fmaxf(v, dppf<0x140>(v));
  return fmaxf(fmaxf(__int_as_float(__builtin_amdgcn_readlane(__float_as_int(v), 0)), __int_as_float(__builtin_amdgcn_readlane(__float_as_int(v), 16))),
               fmaxf(__int_as_float(__builtin_amdgcn_readlane(__float_as_int(v), 32)), __int_as_float(__builtin_amdgcn_readlane(__float_as_int(v), 48))));
}
__device__ __forceinline__ float shflx(float v, int mask, int lane) {
  return __int_as_float(__builtin_amdgcn_ds_bpermute((lane ^ mask) << 2, __float_as_int(v)));
}
#define UNPACK8(raw, f)                                                                                  \
  {                                                                                                      \
    f[0] = bf_lo(raw.x); f[1] = bf_hi(raw.x); f[2] = bf_lo(raw.y); f[3] = bf_hi(raw.y);                  \
    f[4] = bf_lo(raw.z); f[5] = bf_hi(raw.z); f[6] = bf_lo(raw.w); f[7] = bf_hi(raw.w);                  \
  }
#define PACK8(f) ((u32x4){pack_bf16(f[0], f[1]), pack_bf16(f[2], f[3]), pack_bf16(f[4], f[5]), pack_bf16(f[6], f[7])})

constexpr int G_STAGE = 55296, G_BOFF = 36864;
__device__ __forceinline__ void gemm_256x128(const bf16_t* A, int lda, const bf16_t* Bt, int ldb, int K,
                                             f32x4 (&acc)[4][4], char* lds, const int tid) {
  const int lane = tid & 63, wid = tid >> 6, wm = wid >> 1, wn = wid & 1, fr = lane & 15, fq = lane >> 4;
  const int srow = tid >> 3, sch = tid & 7;
  const bf16_t* ag = A + (size_t)srow * lda + sch * 8;
  const bf16_t* bg = Bt + (size_t)srow * ldb + sch * 8;
  u32x4 ra[4], rb[2];
  const int nk = K >> 6;
#pragma unroll
  for (int i = 0; i < 4; ++i) ra[i] = *(const u32x4*)(ag + (size_t)(64 * i) * lda);
#pragma unroll
  for (int i = 0; i < 2; ++i) rb[i] = *(const u32x4*)(bg + (size_t)(64 * i) * ldb);
#pragma unroll
  for (int i = 0; i < 4; ++i) *(u32x4*)(lds + (srow + 64 * i) * 144 + sch * 16) = ra[i];
#pragma unroll
  for (int i = 0; i < 2; ++i) *(u32x4*)(lds + G_BOFF + (srow + 64 * i) * 144 + sch * 16) = rb[i];
  __syncthreads();
  for (int kt = 0; kt < nk; ++kt) {
    const bool more = (kt + 1 < nk);
    if (more) {
#pragma unroll
      for (int i = 0; i < 4; ++i) ra[i] = *(const u32x4*)(ag + (size_t)(64 * i) * lda + (kt + 1) * 64);
#pragma unroll
      for (int i = 0; i < 2; ++i) rb[i] = *(const u32x4*)(bg + (size_t)(64 * i) * ldb + (kt + 1) * 64);
    }
    const char* base = lds + (kt & 1) * G_STAGE;
#pragma unroll
    for (int ks = 0; ks < 2; ++ks) {
      bf16x8 af[4], bfr[4];
#pragma unroll
      for (int mi = 0; mi < 4; ++mi) af[mi] = *(const bf16x8*)(base + (wm * 64 + mi * 16 + fr) * 144 + ks * 64 + fq * 16);
#pragma unroll
      for (int ni = 0; ni < 4; ++ni) bfr[ni] = *(const bf16x8*)(base + G_BOFF + (wn * 64 + ni * 16 + fr) * 144 + ks * 64 + fq * 16);
#pragma unroll
      for (int mi = 0; mi < 4; ++mi)
#pragma unroll
        for (int ni = 0; ni < 4; ++ni) acc[mi][ni] = __builtin_amdgcn_mfma_f32_16x16x32_bf16(bfr[ni], af[mi], acc[mi][ni], 0, 0, 0);
    }
    if (more) {
      char* nb = lds + ((kt + 1) & 1) * G_STAGE;
#pragma unroll
      for (int i = 0; i < 4; ++i) *(u32x4*)(nb + (srow + 64 * i) * 144 + sch * 16) = ra[i];
#pragma unroll
      for (int i = 0; i < 2; ++i) *(u32x4*)(nb + G_BOFF + (srow + 64 * i) * 144 + sch * 16) = rb[i];
    }
    __syncthreads();
  }
}

__device__ __forceinline__ void gemm_256x128_deep(const bf16_t* A, int lda, const bf16_t* Bt, int ldb, int K, f32x4 (&acc)[4][4], char* lds,
                                                  const int tid) {
  const int lane = tid & 63, wid = tid >> 6, wm = wid >> 1, wn = wid & 1, fr = lane & 15, fq = lane >> 4;
  const int srow = tid >> 3, sch = tid & 7;
  const bf16_t* ag = A + (size_t)srow * lda + sch * 8;
  const bf16_t* bg = Bt + (size_t)srow * ldb + sch * 8;
  u32x4 ra0[4], rb0[2], ra1[4], rb1[2];
  const int nk = K >> 6;
#define GLOAD(RA, RB, kt_)                                                                                  \
  {                                                                                                         \
    _Pragma("unroll") for (int i = 0; i < 4; ++i) RA[i] = *(const u32x4*)(ag + (size_t)(64 * i) * lda + (kt_) * 64); \
    _Pragma("unroll") for (int i = 0; i < 2; ++i) RB[i] = *(const u32x4*)(bg + (size_t)(64 * i) * ldb + (kt_) * 64); \
  }
#define LSTORE(RA, RB, st_)                                                                                 \
  {                                                                                                         \
    char* nb_ = lds + (st_) * G_STAGE;                                                                      \
    _Pragma("unroll") for (int i = 0; i < 4; ++i) *(u32x4*)(nb_ + (srow + 64 * i) * 144 + sch * 16) = RA[i]; \
    _Pragma("unroll") for (int i = 0; i < 2; ++i) *(u32x4*)(nb_ + G_BOFF + (srow + 64 * i) * 144 + sch * 16) = RB[i]; \
  }
#define GCOMPUTE(st_)                                                                                       \
  {                                                                                                         \
    const char* base_ = lds + (st_) * G_STAGE;                                                              \
    _Pragma("unroll") for (int ks = 0; ks < 2; ++ks) {                                                      \
      bf16x8 af[4], bfr[4];                                                                                 \
      _Pragma("unroll") for (int mi = 0; mi < 4; ++mi) af[mi] = *(const bf16x8*)(base_ + (wm * 64 + mi * 16 + fr) * 144 + ks * 64 + fq * 16); \
      _Pragma("unroll") for (int ni = 0; ni < 4; ++ni) bfr[ni] = *(const bf16x8*)(base_ + G_BOFF + (wn * 64 + ni * 16 + fr) * 144 + ks * 64 + fq * 16); \
      _Pragma("unroll") for (int mi = 0; mi < 4; ++mi)                                                      \
        _Pragma("unroll") for (int ni = 0; ni < 4; ++ni) acc[mi][ni] = __builtin_amdgcn_mfma_f32_16x16x32_bf16(bfr[ni], af[mi], acc[mi][ni], 0, 0, 0); \
    }                                                                                                       \
  }
  GLOAD(ra0, rb0, 0);
  LSTORE(ra0, rb0, 0);
  GLOAD(ra0, rb0, 1);
  __syncthreads();
#pragma unroll 1
  for (int kt = 0; kt < nk; kt += 2) {
    if (kt + 2 < nk) GLOAD(ra1, rb1, kt + 2);
    GCOMPUTE(0);
    LSTORE(ra0, rb0, 1);
    __syncthreads();
    if (kt + 3 < nk) GLOAD(ra0, rb0, kt + 3);
    GCOMPUTE(1);
    if (kt + 2 < nk) LSTORE(ra1, rb1, 0);
    __syncthreads();
  }
#undef GLOAD
#undef LSTORE
#undef GCOMPUTE
}

#define LAS __attribute__((address_space(3)))
constexpr int D_STAGE = 49152;
__device__ __forceinline__ int dma_lds_byte(int r, int c) {
  const int st = (r >> 4) * 2 + (c >> 5), rr = r & 15, cc = c & 31, ob = rr * 64 + cc * 2;
  return st * 1024 + (ob ^ (((ob >> 9) & 1) << 5));
}
__device__ __forceinline__ void dma_stage_rc(int b, int& R, int& C) {
  const int st = b / 1024, sb = b % 1024, swz = sb ^ (((sb >> 9) & 1) << 5);
  R = (st >> 1) * 16 + swz / 64;
  C = (st & 1) * 32 + (swz % 64) / 2;
}
__device__ __forceinline__ void gemm_256x128_dma(const bf16_t* A, int lda, const bf16_t* Bt, int ldb, int K, f32x4 (&acc)[4][4], char* lds,
                                                 const int tid, const int ksplit = 1 << 30, const int asplit_bytes = 0) {
  const int lane = tid & 63, wid = __builtin_amdgcn_readfirstlane(tid >> 6), wm = wid >> 1, wn = wid & 1, fr = lane & 15, fq = lane >> 4;
  unsigned voffA[2], voffB[2];
#pragma unroll
  for (int i = 0; i < 2; ++i) {
    int R, C;
    dma_stage_rc(tid * 16 + i * 8192, R, C);
    voffA[i] = (unsigned)(R * lda + C) * 2u;
    voffB[i] = (unsigned)(R * ldb + C) * 2u;
  }
  const char* Ab = (const char*)A;
  const char* Bb = (const char*)Bt;
  const size_t ahalf = (size_t)128 * lda * 2;
  LAS char* l3 = (LAS char*)lds;
  const unsigned ldsw = (unsigned)wid * 1024u;
  const int aoff = (wm >> 1) * 16384 + dma_lds_byte((wm & 1) * 64 + fr, fq * 8);
  const int boff = 32768 + dma_lds_byte(wn * 64 + fr, fq * 8);
  const int nk = K >> 6;
#define DMA_STAGE(kt_, sbase_)                                                                                               \
  {                                                                                                                          \
    const char* ga_ = Ab + (size_t)(kt_) * 128 + ((kt_) >= ksplit ? asplit_bytes : 0);                                                                              \
    const char* gb_ = Bb + (size_t)(kt_) * 128;                                                                              \
    _Pragma("unroll") for (int i_ = 0; i_ < 2; ++i_) {                                                                       \
      __builtin_amdgcn_global_load_lds((const unsigned*)(ga_ + voffA[i_]), (LAS unsigned*)(l3 + (sbase_) + ldsw + i_ * 8192), 16, 0, 0);          \
      __builtin_amdgcn_global_load_lds((const unsigned*)(ga_ + ahalf + voffA[i_]), (LAS unsigned*)(l3 + (sbase_) + 16384 + ldsw + i_ * 8192), 16, 0, 0); \
      __builtin_amdgcn_global_load_lds((const unsigned*)(gb_ + voffB[i_]), (LAS unsigned*)(l3 + (sbase_) + 32768 + ldsw + i_ * 8192), 16, 0, 0);  \
    }                                                                                                                        \
  }
  asm volatile("s_waitcnt vmcnt(0)" ::: "memory");
  DMA_STAGE(0, 0);
  DMA_STAGE(1, D_STAGE);
  asm volatile("s_waitcnt vmcnt(6)" ::: "memory");
  __builtin_amdgcn_s_barrier();
  int sc = 0, sn = 2 * D_STAGE;
#pragma unroll 1
  for (int kt = 0; kt < nk; ++kt) {
    const bool pre = kt + 2 < nk;
    if (pre) DMA_STAGE(kt + 2, sn);
    {
      const LAS char* base = l3 + sc;
#pragma unroll
      for (int ks = 0; ks < 2; ++ks) {
        bf16x8 af[4], bfr[4];
#pragma unroll
        for (int mi = 0; mi < 4; ++mi) af[mi] = *(const LAS bf16x8*)(base + aoff + mi * 2048 + ks * 1024);
#pragma unroll
        for (int ni = 0; ni < 4; ++ni) bfr[ni] = *(const LAS bf16x8*)(base + boff + ni * 2048 + ks * 1024);
        __builtin_amdgcn_sched_barrier(0);
#pragma unroll
        for (int mi = 0; mi < 4; ++mi)
#pragma unroll
          for (int ni = 0; ni < 4; ++ni) acc[mi][ni] = __builtin_amdgcn_mfma_f32_16x16x32_bf16(bfr[ni], af[mi], acc[mi][ni], 0, 0, 0);
      }
    }
    if (pre) asm volatile("s_waitcnt vmcnt(6)" ::: "memory");
    else asm volatile("s_waitcnt vmcnt(0)" ::: "memory");
    __builtin_amdgcn_s_barrier();
    sc = (sc == 2 * D_STAGE) ? 0 : sc + D_STAGE;
    sn = (sn == 2 * D_STAGE) ? 0 : sn + D_STAGE;
  }
#undef DMA_STAGE
}

__device__ __forceinline__ void gemm_256x256_dma(const bf16_t* A, int lda, const bf16_t* Bt, int ldb, int K, f32x4 (&acc)[8][4], char* lds,
                                                 const int tid) {
  const int lane = tid & 63, wid = __builtin_amdgcn_readfirstlane(tid >> 6), wm = wid >> 2, wn = wid & 3, fr = lane & 15, fq = lane >> 4;
  unsigned voffA[2], voffB[2];
#pragma unroll
  for (int i = 0; i < 2; ++i) {
    int R, C;
    dma_stage_rc(tid * 16 + i * 8192, R, C);
    voffA[i] = (unsigned)(R * lda + C) * 2u;
    voffB[i] = (unsigned)(R * ldb + C) * 2u;
  }
  const char* Ab = (const char*)A;
  const char* Bb = (const char*)Bt;
  const size_t ahalf = (size_t)128 * lda * 2, bhalf = (size_t)128 * ldb * 2;
  LAS char* l3 = (LAS char*)lds;
  const unsigned ldsw = (unsigned)wid * 1024u;
  const int aoff = wm * 16384 + dma_lds_byte(fr, fq * 8);
  const int boff = 32768 + (wn >> 1) * 16384 + dma_lds_byte((wn & 1) * 64 + fr, fq * 8);
  const int nk = K >> 6;
#define DMA_STAGE4(kt_, sbase_)                                                                                              \
  {                                                                                                                          \
    const char* ga_ = Ab + (size_t)(kt_) * 128;                                                                              \
    const char* gb_ = Bb + (size_t)(kt_) * 128;                                                                              \
    _Pragma("unroll") for (int i_ = 0; i_ < 2; ++i_) {                                                                       \
      __builtin_amdgcn_global_load_lds((const unsigned*)(ga_ + voffA[i_]), (LAS unsigned*)(l3 + (sbase_) + ldsw + i_ * 8192), 16, 0, 0);          \
      __builtin_amdgcn_global_load_lds((const unsigned*)(ga_ + ahalf + voffA[i_]), (LAS unsigned*)(l3 + (sbase_) + 16384 + ldsw + i_ * 8192), 16, 0, 0); \
      __builtin_amdgcn_global_load_lds((const unsigned*)(gb_ + voffB[i_]), (LAS unsigned*)(l3 + (sbase_) + 32768 + ldsw + i_ * 8192), 16, 0, 0);  \
      __builtin_amdgcn_global_load_lds((const unsigned*)(gb_ + bhalf + voffB[i_]), (LAS unsigned*)(l3 + (sbase_) + 49152 + ldsw + i_ * 8192), 16, 0, 0); \
    }                                                                                                                        \
  }
  asm volatile("s_waitcnt vmcnt(0)" ::: "memory");
  DMA_STAGE4(0, 0);
  asm volatile("s_waitcnt vmcnt(0)" ::: "memory");
  __builtin_amdgcn_s_barrier();
#pragma unroll 1
  for (int kt = 0; kt < nk; ++kt) {
    const int sc = (kt & 1) * 65536;
    if (kt + 1 < nk) DMA_STAGE4(kt + 1, 65536 - sc);
    {
      const LAS char* base = l3 + sc;
#pragma unroll
      for (int ks = 0; ks < 2; ++ks) {
        bf16x8 af[8], bfr[4];
#pragma unroll
        for (int ni = 0; ni < 4; ++ni) bfr[ni] = *(const LAS bf16x8*)(base + boff + ni * 2048 + ks * 1024);
#pragma unroll
        for (int mi = 0; mi < 8; ++mi) af[mi] = *(const LAS bf16x8*)(base + aoff + mi * 2048 + ks * 1024);
        __builtin_amdgcn_sched_barrier(0);
#pragma unroll
        for (int mi = 0; mi < 8; ++mi)
#pragma unroll
          for (int ni = 0; ni < 4; ++ni) acc[mi][ni] = __builtin_amdgcn_mfma_f32_16x16x32_bf16(bfr[ni], af[mi], acc[mi][ni], 0, 0, 0);
      }
    }
    asm volatile("s_waitcnt vmcnt(0)" ::: "memory");
    __builtin_amdgcn_s_barrier();
  }
#undef DMA_STAGE4
}

__device__ void phase_mod(const Params& p, char* lds) {
  const int tid = opaque_tid();
  float* sc = (float*)lds;
  for (int i = tid; i < 9 * 1024; i += NTHR) {
    int s = i >> 10, k = i & 1023;
    float v = s < 8 ? p.c[s * 1024 + k] : p.c_ctx[k];
    sc[i] = siluf_(v);
  }
  __syncthreads();
  float* red = sc + 9 * 1024;
  for (int u = blockIdx.x; u < NL * 48; u += gridDim.x) {
    const int l = u / 48, n0 = (u % 48) * 64, col = tid & 63, kq = tid >> 6;
    const float* w = p.w_mod + (size_t)l * 1024 * 3072 + (size_t)(kq * 128) * 3072 + n0 + col;
    float a[9];
#pragma unroll
    for (int s = 0; s < 9; ++s) a[s] = 0.f;
#pragma unroll 4
    for (int k = 0; k < 128; ++k) {
      float wv = w[(size_t)k * 3072];
#pragma unroll
      for (int s = 0; s < 9; ++s) a[s] += sc[s * 1024 + kq * 128 + k] * wv;
    }
#pragma unroll
    for (int s = 0; s < 9; ++s) red[(kq * 64 + col) * 9 + s] = a[s];
    __syncthreads();
    for (int o = tid; o < 576; o += NTHR) {
      int cc = o / 9, s = o % 9;
      float t = 0.f;
#pragma unroll
      for (int q = 0; q < 8; ++q) t += red[(q * 64 + cc) * 9 + s];
      WS_MOD(p)[((size_t)l * 9 + s) * 3072 + n0 + cc] = t + p.b_mod[l * 3072 + n0 + cc];
    }
    __syncthreads();
  }
}

__device__ __forceinline__ void cvt_tile(const float* src, int ldsrc, bf16_t* dst, int K, int k0, int n0, float* tl, const int tid) {
#pragma unroll
  for (int i = 0; i < 2; ++i) {
    int kk = (tid >> 4) + 32 * i, nn = (tid & 15) * 4;
    f32x4 v = *(const f32x4*)(src + (size_t)(k0 + kk) * ldsrc + n0 + nn);
    tl[kk * 65 + nn + 0] = v.x; tl[kk * 65 + nn + 1] = v.y; tl[kk * 65 + nn + 2] = v.z; tl[kk * 65 + nn + 3] = v.w;
  }
  __syncthreads();
  {
    int n = tid >> 3, k8 = (tid & 7) * 8;
    float f[8];
#pragma unroll
    for (int e = 0; e < 8; ++e) f[e] = tl[(k8 + e) * 65 + n];
    *(u32x4*)(dst + (size_t)(n0 + n) * K + k0 + k8) = PACK8(f);
  }
  __syncthreads();
}
__device__ void phase_cvt(const Params& p, int l, char* lds, int rank, int stride) {
  const int tid = opaque_tid();
  float* tl = (float*)lds;
  const size_t wso = (size_t)(l & 1) * WSET;
  const float* win = p.w_in + (size_t)l * D * NIN;
  const float* wbr = p.w_branch + (size_t)l * 3 * 512 * D;
  const float* wo = p.w_out + (size_t)l * D * D;
  for (int u = rank; u < 3008; u += stride) {
    if (u < 2368) {
      int kt = u / 148, nt = u % 148;
      if (nt < 100) cvt_tile(win, NIN, WS_WIN(p) + wso, D, kt * 64, nt * 64, tl, tid);
      else cvt_tile(win + 6400, NIN, WS_WG(p) + wso, D, kt * 64, (nt - 100) * 64, tl, tid);
    } else if (u < 2368 + 384) {
      int v = u - 2368, i = v / 128, r = v % 128, kt = r / 16, nt = r % 16;
      cvt_tile(wbr + (size_t)i * 512 * D, D, WS_WB(p) + wso + (size_t)i * D * 512, 512, kt * 64, nt * 64, tl, tid);
    } else {
      int v = u - 2752, kt = v / 16, nt = v % 16;
      cvt_tile(wo, D, WS_WO(p) + wso, D, kt * 64, nt * 64, tl, tid);
    }
  }
}

__device__ __forceinline__ const float* xrow_src(const Params& p, int l, int b, int s) {
  return (s < CTX) ? ((l == 0 ? p.ctx : WS_CTXS(p)) + ((size_t)b * CTX + s) * D) : ((l == 0 ? p.x : p.out) + ((size_t)b * T + (s - CTX)) * D);
}
__device__ void phase_norm(const Params& p, int l) {
  const int tid = opaque_tid();
  const int gw = blockIdx.x * 8 + (tid >> 6), nw = gridDim.x * 8, lane = tid & 63;
  const float* ng = p.norm_g + l * D;
  for (int row = gw; row < M; row += nw) {
    const int b = row / S, s = row % S;
    const float* xr = xrow_src(p, l, b, s);
#ifndef PROBE_NORM
#define PROBE_NORM 0
#endif
    const float* md = WS_MOD(p) + ((size_t)(PROBE_NORM == 1 ? 0 : l) * 9 + (s < CTX ? 8 : b)) * 3072;
    f32x4 v[4];
    float ss = 0.f;
#pragma unroll
    for (int i = 0; i < 4; ++i) {
      v[i] = *(const f32x4*)(xr + i * 256 + lane * 4);
      ss += v[i].x * v[i].x + v[i].y * v[i].y + v[i].z * v[i].z + v[i].w * v[i].w;
    }
    ss = wave_sum(ss);
    const float rstd = rsqrtf(ss * (1.f / 1024.f) + 1e-6f);
#pragma unroll
    for (int i = 0; i < 4; ++i) {
      const int col = i * 256 + lane * 4;
      f32x4 g = *(const f32x4*)(ng + col), sh = *(const f32x4*)(md + col), sc = *(const f32x4*)(md + 1024 + col);
      f32x4 y = v[i] * rstd * g * (1.f + sc) + sh;
      u32x2 o = {pack_bf16(y.x, y.y), pack_bf16(y.z, y.w)};
      *(u32x2*)(WS_H(p) + (size_t)row * D + col) = o;
    }
  }
}

__device__ void phase_inproj(const Params& p, int l, char* lds) {
  const int tid = opaque_tid(), lane = tid & 63, wid = tid >> 6, wm = wid >> 2, wn = wid & 3, fr = lane & 15, fq = lane >> 4;
  const int xcd = blockIdx.x & 7, bi = blockIdx.x >> 3, nbx = (gridDim.x + 7 - xcd) >> 3;
  for (int idx = bi; idx < 17 * 25; idx += nbx) {
    int ml, nl, mg, ng;
    if (idx < 400) {
      mg = idx / 100;
      const int rem = idx - mg * 100;
      ng = rem >> 5;
      const int rem2 = rem & 31;
      if (ng < 3) { ml = rem2 & 3; nl = rem2 >> 2; } else { ml = rem2; nl = 0; }
    } else { mg = 4; ng = 0; ml = 0; nl = idx - 400; }
    const int mt = 17 * xcd + mg * 4 + ml, nt = ng * 8 + nl;
    f32x4 acc[8][4];
#pragma unroll
    for (int mi = 0; mi < 8; ++mi)
#pragma unroll
      for (int ni = 0; ni < 4; ++ni) acc[mi][ni] = (f32x4){0.f, 0.f, 0.f, 0.f};
    gemm_256x256_dma(WS_H(p) + (size_t)mt * 256 * D, D, WS_WIN(p) + (size_t)(l & 1) * WSET + (size_t)nt * 256 * D, D, D, acc, lds, tid);
    const bool dotanh = (nt == 6) && (wn < 2);
    char* wl = lds + wid * 18432;
#pragma unroll
    for (int mi = 0; mi < 8; ++mi)
#pragma unroll
      for (int ni = 0; ni < 4; ++ni) {
        f32x4 v = mfma_guard(acc[mi][ni]);
        if (dotanh) { v.x = tanhf_(v.x); v.y = tanhf_(v.y); v.z = tanhf_(v.z); v.w = tanhf_(v.w); }
        const u32x2 o = {pack_bf16(v.x, v.y), pack_bf16(v.z, v.w)};
        *(u32x2*)(wl + (mi * 16 + fr) * 144 + (ni * 16 + 4 * fq) * 2) = o;
      }
    {
      const int rr = lane >> 3, cc = lane & 7;
      bf16_t* gbase = WS_PROJ(p) + (size_t)(mt * 256 + wm * 128) * NP + nt * 256 + wn * 64 + cc * 8;
#pragma unroll
      for (int j = 0; j < 16; ++j) {
        const int r = j * 8 + rr;
        const u32x4 o = *(const u32x4*)(wl + r * 144 + cc * 16);
        *(u32x4*)(gbase + (size_t)r * NP) = o;
      }
    }
    __syncthreads();
  }
}

__device__ __forceinline__ void prep_token(const Params& p, int l, int row, int lane) {
  const int s = row % S;
  const bool lat = s >= CTX;
  const int t = s - CTX;
  bf16_t* pr = WS_PROJ(p) + (size_t)row * NP;
  const int gi = lane & 7, d0 = gi * 8;
  float cs[8], sn[8];
  if (lat) {
    const float pos = (gi >> 2) ? (float)(t & 63) : (float)(t >> 6);
#pragma unroll
    for (int e = 0; e < 8; ++e) {
      float fr_ = __builtin_amdgcn_exp2f(-(float)((gi & 1) * 8 + e) * 0.830482024f);
      float rev = pos * fr_ * 0.15915494309f;
      rev = rev - floorf(rev);
      cs[e] = __builtin_amdgcn_cosf(rev);
      sn[e] = __builtin_amdgcn_sinf(rev);
    }
  } else {
#pragma unroll
    for (int e = 0; e < 8; ++e) { cs[e] = 1.f; sn[e] = 0.f; }
  }
  const float sgn = ((gi >> 1) & 1) ? 1.f : -1.f;
#pragma unroll
  for (int which = 0; which < 2; ++which) {
    bf16_t* ptr = pr + (which ? C_KD : C_QD) + lane * 8;
    const float* g = p.qk_norm_g + l * 128 + which * 64 + d0;
    u32x4 raw = *(const u32x4*)ptr;
    float x[8], y[8];
    UNPACK8(raw, x);
    float ss = 0.f;
#pragma unroll
    for (int e = 0; e < 8; ++e) ss += x[e] * x[e];
    ss = grp8_sum(ss);
    const float rstd = rsqrtf(ss * (1.f / 64.f) + 1e-6f);
    const float osc = which ? 1.f : 0.18033688011f;
#pragma unroll
    for (int e = 0; e < 8; ++e) y[e] = x[e] * rstd * g[e];
#pragma unroll
    for (int e = 0; e < 8; ++e) {
      float pv = dppf<0x4E>(y[e]);
      x[e] = (y[e] * cs[e] + sgn * pv * sn[e]) * osc;
    }
    *(u32x4*)ptr = PACK8(x);
  }
  u32x4 kkp;
  {
    u32x4 raw = *(const u32x4*)(pr + C_K + lane * 8);
    float x[8];
    UNPACK8(raw, x);
    const float* kkw = p.k_k + l * 512 + lane * 8;
    float ss = 0.f;
#pragma unroll
    for (int e = 0; e < 8; ++e) { x[e] *= kkw[e]; ss += x[e] * x[e]; }
    ss = grp8_sum(ss);
    const float rn = rsqrtf(ss + 1e-12f);
#pragma unroll
    for (int e = 0; e < 8; ++e) x[e] *= rn;
    kkp = PACK8(x);
  }
  {
    const int sp = lat ? t : s, sl = lat ? T : CTX;
    float gb[8], zb[8], g0[8], u0[8], gm[8], um[8], gp[8], up[8];
    u32x4 raw;
    raw = *(const u32x4*)(pr + C_GB + lane * 8); UNPACK8(raw, gb);
    raw = *(const u32x4*)(pr + C_ZB + lane * 8); UNPACK8(raw, zb);
    raw = *(const u32x4*)(pr + C_GC + lane * 8); UNPACK8(raw, g0);
    raw = *(const u32x4*)(pr + C_U + lane * 8); UNPACK8(raw, u0);
    if (sp > 0) {
      raw = *(const u32x4*)(pr - NP + C_GC + lane * 8); UNPACK8(raw, gm);
      raw = *(const u32x4*)(pr - NP + C_U + lane * 8); UNPACK8(raw, um);
    } else {
#pragma unroll
      for (int e = 0; e < 8; ++e) { gm[e] = 0.f; um[e] = 0.f; }
    }
    if (sp < sl - 1) {
      raw = *(const u32x4*)(pr + NP + C_GC + lane * 8); UNPACK8(raw, gp);
      raw = *(const u32x4*)(pr + NP + C_U + lane * 8); UNPACK8(raw, up);
    } else {
#pragma unroll
      for (int e = 0; e < 8; ++e) { gp[e] = 0.f; up[e] = 0.f; }
    }
    const float* cw = p.conv_w + l * 3 * 512 + lane * 8;
    const float* cb = p.conv_b + l * 512 + lane * 8;
    float y[8];
#pragma unroll
    for (int e = 0; e < 8; ++e) {
      float cv = cw[e] * gm[e] * um[e] + cw[512 + e] * g0[e] * u0[e] + cw[1024 + e] * gp[e] * up[e] + cb[e];
      y[e] = gb[e] * cv * siluf_(zb[e]);
    }
    *(u32x4*)(pr + C_YB + lane * 8) = PACK8(y);
  }
  *(u32x4*)(pr + C_KK + lane * 8) = kkp;
}
__device__ void phase_prep(const Params& p, int l, char* lds) {
  const int tid = opaque_tid(), lane = tid & 63, wid = tid >> 6;
  const int nspan = M / 136;
  for (int sp = blockIdx.x; sp < nspan; sp += gridDim.x) {
    const int row0 = sp * 136, b = row0 / S, s0 = row0 % S;
    for (int i = tid; i < 136 * 64; i += NTHR) {
      const int tok = i >> 6, ch = i & 63;
      *(u32x4*)(lds + tok * 1040 + ch * 16) = *(const u32x4*)(WS_PROJ(p) + (size_t)(row0 + tok) * NP + C_VD + ch * 8);
    }
    __syncthreads();
    for (int i = tid; i < 512 * 17; i += NTHR) {
      const int dv = i / 17, cch = i - dv * 17, head = dv >> 7, dvl = dv & 127;
      unsigned short e[8];
#pragma unroll
      for (int q = 0; q < 8; ++q) e[q] = *(const unsigned short*)(lds + (cch * 8 + q) * 1040 + dv * 2);
      u32x4 o = {(unsigned)e[0] | ((unsigned)e[1] << 16), (unsigned)e[2] | ((unsigned)e[3] << 16), (unsigned)e[4] | ((unsigned)e[5] << 16),
                 (unsigned)e[6] | ((unsigned)e[7] << 16)};
      *(u32x4*)(WS_VT(p) + ((size_t)(b * 4 + head) * 128 + dvl) * S + s0 + cch * 8) = o;
    }
    for (int i = 0; i < 17; ++i) prep_token(p, l, row0 + wid * 17 + i, lane);
    __syncthreads();
  }
}

constexpr int SC_CH = 32;
constexpr int SC_TS = 68, SC_VS = 36;
constexpr int SC_ARR = SC_CH * SC_TS * 4;
constexpr int SC_R = 0, SC_KK = SC_ARR, SC_W = 2 * SC_ARR, SC_KD = 3 * SC_ARR, SC_AK = 4 * SC_ARR, SC_V = 5 * SC_ARR, SC_BUF = 5 * SC_ARR + SC_CH * SC_VS * 4;
constexpr int SC_Y = 2 * SC_BUF;
constexpr int SC_WF = SC_Y + 8192;
__device__ __forceinline__ int scan_row(int b, int dir, int j) {
  const int s = dir == 0 ? j : (j < CTX ? (CTX - 1 - j) : (S + CTX - 1 - j));
  return b * S + s;
}
__device__ void phase_scan(const Params& p, int l, char* lds) {
  const int tid = opaque_tid(), lane = tid & 63, wid = tid >> 6, fr = lane & 15, fq = lane >> 4;
  for (int u = blockIdx.x; u < 256; u += gridDim.x) {
    const int pr_ = (u & 7) * 8 + (u >> 5), hd_ = (u >> 3) & 3;
    const int half = hd_ & 1, dir = hd_ >> 1, h = pr_ & 7, b = pr_ >> 3;
    const int c_lw = dir ? C_LWB : C_LWF, c_la = dir ? C_LAB : C_LAF, c_ys = dir ? C_YSB : C_YSF;
    if (wid == 4) {
      const float* du = p.decay_up + (size_t)(l * 2 + dir) * 64 * 512 + h * 64;
      const float* iu = p.iclr_up + (size_t)(l * 2 + dir) * 64 * 512 + h * 64;
#pragma unroll 1
      for (int f8 = 0; f8 < 8; ++f8) {
        const int nt = f8 >> 1, ks = f8 & 1;
        float fd[8], fi[8];
#pragma unroll
        for (int e = 0; e < 8; ++e) {
          const int k = ks * 32 + fq * 8 + e;
          fd[e] = du[(size_t)k * 512 + nt * 16 + fr];
          fi[e] = iu[(size_t)k * 512 + nt * 16 + fr];
        }
        *(u32x4*)(lds + SC_WF + (f8 * 64 + lane) * 16) = PACK8(fd);
        *(u32x4*)(lds + SC_WF + 8192 + (f8 * 64 + lane) * 16) = PACK8(fi);
      }
    }
    __syncthreads();
    const int pq = wid - 4, pth = pq & 1, pn0 = (pq >> 1) * 2, pti = pth * 16 + fr;
    bf16x8 P_tl[2], P_ta[2];
    u32x2 P_r[2], P_k[2], P_kk[2];
    u32x2 P_v;
    auto pload = [&](int c) {
      const bf16_t* pr = WS_PROJ(p) + (size_t)scan_row(b, dir, c * SC_CH + pti) * NP;
#pragma unroll
      for (int ks = 0; ks < 2; ++ks) {
        P_tl[ks] = *(const bf16x8*)(pr + c_lw + ks * 32 + fq * 8);
        P_ta[ks] = *(const bf16x8*)(pr + c_la + ks * 32 + fq * 8);
      }
#pragma unroll
      for (int n2 = 0; n2 < 2; ++n2) {
        const int gch = h * 64 + (pn0 + n2) * 16 + 4 * fq;
        P_r[n2] = *(const u32x2*)(pr + C_R + gch);
        P_k[n2] = *(const u32x2*)(pr + C_K + gch);
        P_kk[n2] = *(const u32x2*)(pr + C_KK + gch);
      }
      P_v = *(const u32x2*)(pr + C_V + h * 64 + half * 32 + (pq >> 1) * 16 + fq * 4);
    };
    f32x4 Cw0[2], Ca0[2], Cka[2];
    if (wid >= 4) {
#pragma unroll
      for (int n2 = 0; n2 < 2; ++n2) {
        const int gch = h * 64 + (pn0 + n2) * 16 + 4 * fq;
        Cw0[n2] = *(const f32x4*)(p.decay_w0 + (l * 2 + dir) * 512 + gch);
        Ca0[n2] = *(const f32x4*)(p.iclr_a0 + (l * 2 + dir) * 512 + gch);
        Cka[n2] = *(const f32x4*)(p.k_a + l * 512 + gch);
      }
    }
    auto pcompute = [&](int c) {
      char* buf = lds + (c & 1) * SC_BUF;
#pragma unroll
      for (int n2 = 0; n2 < 2; ++n2) {
        const int nt = pn0 + n2;
        f32x4 aw = {0.f, 0.f, 0.f, 0.f}, aa = {0.f, 0.f, 0.f, 0.f};
#pragma unroll
        for (int ks = 0; ks < 2; ++ks) {
          const bf16x8 wd = *(const bf16x8*)(lds + SC_WF + ((nt * 2 + ks) * 64 + lane) * 16);
          const bf16x8 wi = *(const bf16x8*)(lds + SC_WF + 8192 + ((nt * 2 + ks) * 64 + lane) * 16);
          aw = __builtin_amdgcn_mfma_f32_16x16x32_bf16(wd, P_tl[ks], aw, 0, 0, 0);
          aa = __builtin_amdgcn_mfma_f32_16x16x32_bf16(wi, P_ta[ks], aa, 0, 0, 0);
        }
        const int ch = nt * 16 + 4 * fq, gch = h * 64 + ch;
        const f32x4 w0 = Cw0[n2], a0 = Ca0[n2], ka = Cka[n2];
        const u32x2 r2 = P_r[n2], k2 = P_k[n2], kk2 = P_kk[n2];
        const f32x4 rv = {bf_lo(r2.x), bf_hi(r2.x), bf_lo(r2.y), bf_hi(r2.y)};
        const f32x4 kv = {bf_lo(k2.x), bf_hi(k2.x), bf_lo(k2.y), bf_hi(k2.y)};
        const f32x4 kkv = {bf_lo(kk2.x), bf_hi(kk2.x), bf_lo(kk2.y), bf_hi(kk2.y)};
        f32x4 wv, kd, ak;
#pragma unroll
        for (int j = 0; j < 4; ++j) {
          const float sg = sigmoidf_(aw[j] + w0[j]);
          wv[j] = __expf(-0.6065306597f * sg);
          const float a = sigmoidf_(aa[j] + a0[j]);
          kd[j] = kv[j] * (1.f + (a - 1.f) * ka[j]);
          ak[j] = a * kkv[j];
        }
        const int o = (pti * SC_TS + ch) * 4;
        *(f32x4*)(buf + SC_R + o) = rv;
        *(f32x4*)(buf + SC_KK + o) = kkv;
        *(f32x4*)(buf + SC_W + o) = wv;
        *(f32x4*)(buf + SC_KD + o) = kd;
        *(f32x4*)(buf + SC_AK + o) = ak;
      }
      *(f32x4*)(buf + SC_V + (pti * SC_VS + (pq >> 1) * 16 + fq * 4) * 4) = (f32x4){bf_lo(P_v.x), bf_hi(P_v.x), bf_lo(P_v.y), bf_hi(P_v.y)};
    };
    auto flush_y = [&](int c) {
      const int pt = tid - 256, tok = pt >> 3, r4 = (pt & 7) * 4;
      const f32x4 yv = *(const f32x4*)((const float*)(lds + SC_Y) + (c & 1) * 1024 + tok * 32 + r4);
      const int row = scan_row(b, dir, c * SC_CH + tok);
      const u32x2 o = {pack_bf16(yv.x, yv.y), pack_bf16(yv.z, yv.w)};
      *(u32x2*)(WS_PROJ(p) + (size_t)row * NP + c_ys + h * 64 + half * 32 + r4) = o;
    };
    const int nchunk = S / SC_CH;
    if (wid >= 4) { pload(0); pcompute(0); pload(1); }
    __syncthreads();
    f32x2 S2[4];
#pragma unroll
    for (int i = 0; i < 4; ++i) S2[i] = (f32x2){0.f, 0.f};
    const int rl = lane >> 3, cg8 = lane & 7;
    for (int c = 0; c < nchunk; ++c) {
      if (wid < 4) {
        const char* buf = lds + (c & 1) * SC_BUF;
        float* yb = (float*)(lds + SC_Y) + (c & 1) * 1024;
#define SC_LOAD(P, i_)                                                                                         \
  {                                                                                                            \
    const int o_ = ((i_) * SC_TS + cg8 * 8) * 4;                                                                  \
    P##ka = *(const f32x4*)(buf + SC_KK + o_); P##kb = *(const f32x4*)(buf + SC_KK + o_ + 16);                 \
    P##wa = *(const f32x4*)(buf + SC_W + o_);  P##wb = *(const f32x4*)(buf + SC_W + o_ + 16);                  \
    P##da = *(const f32x4*)(buf + SC_KD + o_); P##db = *(const f32x4*)(buf + SC_KD + o_ + 16);                 \
    P##aa = *(const f32x4*)(buf + SC_AK + o_); P##ab = *(const f32x4*)(buf + SC_AK + o_ + 16);                 \
    P##ra = *(const f32x4*)(buf + SC_R + o_);  P##rb = *(const f32x4*)(buf + SC_R + o_ + 16);                  \
    P##vv = *(const float*)(buf + SC_V + ((i_) * SC_VS + wid * 8 + rl) * 4);                                      \
  }
#define SC_STEP(P, i_)                                                                                         \
  {                                                                                                            \
    f32x2 d2 = S2[0] * (f32x2){P##ka.x, P##ka.y};                                                              \
    d2 = __builtin_elementwise_fma(S2[1], (f32x2){P##ka.z, P##ka.w}, d2);                                      \
    d2 = __builtin_elementwise_fma(S2[2], (f32x2){P##kb.x, P##kb.y}, d2);                                      \
    d2 = __builtin_elementwise_fma(S2[3], (f32x2){P##kb.z, P##kb.w}, d2);                                      \
      \
    float ra_ = d2.x + d2.y, rb_ = ypend;                                                                     \
    ra_ += dppf<0xB1>(ra_); rb_ += dppf<0xB1>(rb_);                                                            \
    ra_ += dppf<0x4E>(ra_); rb_ += dppf<0x4E>(rb_);                                                            \
    ra_ += dppf<0x141>(ra_); rb_ += dppf<0x141>(rb_);                                                          \
    yb[((i_) > 0 ? (i_) - 1 : 0) * 32 + wid * 8 + rl] = rb_;     \
    const float skk = ra_;                                                                                     \
    const f32x2 v2 = {P##vv, P##vv}, nk2 = {-skk, -skk};                                                       \
    f32x2 t0 = v2 * (f32x2){P##da.x, P##da.y}, t1 = v2 * (f32x2){P##da.z, P##da.w};                            \
    f32x2 t2 = v2 * (f32x2){P##db.x, P##db.y}, t3 = v2 * (f32x2){P##db.z, P##db.w};                            \
    t0 = __builtin_elementwise_fma(nk2, (f32x2){P##aa.x, P##aa.y}, t0);                                        \
    t1 = __builtin_elementwise_fma(nk2, (f32x2){P##aa.z, P##aa.w}, t1);                                        \
    t2 = __builtin_elementwise_fma(nk2, (f32x2){P##ab.x, P##ab.y}, t2);                                        \
    t3 = __builtin_elementwise_fma(nk2, (f32x2){P##ab.z, P##ab.w}, t3);                                        \
    S2[0] = __builtin_elementwise_fma(S2[0], (f32x2){P##wa.x, P##wa.y}, t0);                                   \
    S2[1] = __builtin_elementwise_fma(S2[1], (f32x2){P##wa.z, P##wa.w}, t1);                                   \
    S2[2] = __builtin_elementwise_fma(S2[2], (f32x2){P##wb.x, P##wb.y}, t2);                                   \
    S2[3] = __builtin_elementwise_fma(S2[3], (f32x2){P##wb.z, P##wb.w}, t3);                                   \
    f32x2 y2 = S2[0] * (f32x2){P##ra.x, P##ra.y};                                                              \
    y2 = __builtin_elementwise_fma(S2[1], (f32x2){P##ra.z, P##ra.w}, y2);                                      \
    y2 = __builtin_elementwise_fma(S2[2], (f32x2){P##rb.x, P##rb.y}, y2);                                      \
    y2 = __builtin_elementwise_fma(S2[3], (f32x2){P##rb.z, P##rb.w}, y2);                                      \
    ypend = y2.x + y2.y;                                         \
  }
        f32x4 Aka, Akb, Awa, Awb, Ada, Adb, Aaa, Aab, Ara, Arb, Bka, Bkb, Bwa, Bwb, Bda, Bdb, Baa, Bab, Bra, Brb;
        float Avv, Bvv, ypend = 0.f;
        SC_LOAD(A, 0);
#pragma unroll 2
        for (int i = 0; i < SC_CH; i += 2) {
          SC_LOAD(B, i + 1);
          SC_STEP(A, i);
          if (i + 2 < SC_CH) SC_LOAD(A, i + 2);
          SC_STEP(B, i + 1);
        }
        yb[(SC_CH - 1) * 32 + wid * 8 + rl] = allreduce8(ypend);
      } else {
        if (c + 1 < nchunk) pcompute(c + 1);
        if (c + 2 < nchunk) pload(c + 2);
        if (c > 0) flush_y(c - 1);
      }
      __syncthreads();
    }
    if (wid >= 4) flush_y(nchunk - 1);
    __syncthreads();
  }
}

constexpr int A_STAGE = 35840, A_VOFF = 17408, A_VSTR = 136;
__device__ void attn_unit(const Params& p, int l, int b, int head, int q0, int nkt, float lam, float lam_init, float bound2, char* lds) {
  int lane = __builtin_amdgcn_mbcnt_hi(~0u, __builtin_amdgcn_mbcnt_lo(~0u, 0u));
  asm volatile("" : "+v"(lane));
  const int wid = __builtin_amdgcn_readfirstlane(threadIdx.x >> 6), tid = wid * 64 + lane, fr = lane & 15, fq = lane >> 4;
  const int qrow = b * S + q0 + wid * 16 + fr;
  bf16x8 qf[2][2];
#pragma unroll
  for (int c = 0; c < 2; ++c)
#pragma unroll
    for (int ks = 0; ks < 2; ++ks) qf[c][ks] = *(const bf16x8*)(WS_PROJ(p) + (size_t)qrow * NP + C_QD + head * 128 + c * 64 + ks * 32 + fq * 8);
  f32x4 O[2][8];
  float ls[2] = {0.f, 0.f};
#pragma unroll
  for (int c = 0; c < 2; ++c)
#pragma unroll
    for (int dt = 0; dt < 8; ++dt) O[c][dt] = (f32x4){0.f, 0.f, 0.f, 0.f};
  const bf16_t* kg = WS_PROJ(p) + (size_t)(b * S + (tid >> 4)) * NP + C_KD + head * 128 + (tid & 15) * 8;
  const bf16_t* vg = WS_VT(p) + ((size_t)(b * 4 + head) * 128 + (tid >> 3)) * S + (tid & 7) * 8;
  const int ksto = (tid >> 4) * 272 + (tid & 15) * 16, vsto = A_VOFF + (tid >> 3) * A_VSTR + (tid & 7) * 16;
  u32x4 rk[2], rv[2];
#pragma unroll
  for (int i = 0; i < 2; ++i) {
    rk[i] = *(const u32x4*)(kg + (size_t)(32 * i) * NP);
    rv[i] = *(const u32x4*)(vg + (size_t)(64 * i) * S);
  }
#pragma unroll
  for (int i = 0; i < 2; ++i) {
    *(u32x4*)(lds + ksto + i * 32 * 272) = rk[i];
    *(u32x2*)(lds + vsto + i * 64 * A_VSTR) = (u32x2){rv[i].x, rv[i].y};
    *(u32x2*)(lds + vsto + i * 64 * A_VSTR + 8) = (u32x2){rv[i].z, rv[i].w};
  }
  __syncthreads();
  for (int kt = 0; kt < nkt; ++kt) {
    const char* base = lds + (kt & 1) * A_STAGE;
    const bool more = kt + 1 < nkt;
    if (more) {
#pragma unroll
      for (int i = 0; i < 2; ++i) {
        rk[i] = *(const u32x4*)(kg + (size_t)((kt + 1) * 64 + 32 * i) * NP);
        rv[i] = *(const u32x4*)(vg + (size_t)(64 * i) * S + (kt + 1) * 64);
      }
    }
#pragma unroll
    for (int g = 0; g < 2; ++g) {
      bf16x8 pf[2];
#pragma unroll
      for (int c = 0; c < 2; ++c) {
        f32x4 sa[2];
        sa[0] = (f32x4){-bound2, -bound2, -bound2, -bound2};
        sa[1] = sa[0];
#pragma unroll
        for (int ks = 0; ks < 2; ++ks)
#pragma unroll
          for (int k2 = 0; k2 < 2; ++k2) {
            const bf16x8 kf = *(const bf16x8*)(base + ((g * 2 + k2) * 16 + fr) * 272 + (c * 64 + ks * 32 + fq * 8) * 2);
            sa[k2] = __builtin_amdgcn_mfma_f32_16x16x32_bf16(kf, qf[c][ks], sa[k2], 0, 0, 0);
          }
        float acc_l = 0.f;
#pragma unroll
        for (int k2 = 0; k2 < 2; ++k2)
#pragma unroll
          for (int j = 0; j < 4; ++j) {
            const float pe = __builtin_amdgcn_exp2f(sa[k2][j]);
            sa[k2][j] = pe;
            acc_l += pe;
          }
        ls[c] += acc_l;
        u32x4 pk = {pack_bf16_b(sa[0][0], sa[0][1]), pack_bf16_b(sa[0][2], sa[0][3]), pack_bf16_b(sa[1][0], sa[1][1]), pack_bf16_b(sa[1][2], sa[1][3])};
        pf[c] = __builtin_bit_cast(bf16x8, pk);
      }
#pragma unroll
      for (int dt = 0; dt < 8; ++dt) {
        const u32x2 v0 = *(const u32x2*)(base + A_VOFF + (dt * 16 + fr) * A_VSTR + (g * 32 + 4 * fq) * 2);
        const u32x2 v1 = *(const u32x2*)(base + A_VOFF + (dt * 16 + fr) * A_VSTR + (g * 32 + 16 + 4 * fq) * 2);
        const u32x4 vv = {v0.x, v0.y, v1.x, v1.y};
        const bf16x8 vf = __builtin_bit_cast(bf16x8, vv);
        O[0][dt] = __builtin_amdgcn_mfma_f32_16x16x32_bf16(vf, pf[0], O[0][dt], 0, 0, 0);
        O[1][dt] = __builtin_amdgcn_mfma_f32_16x16x32_bf16(vf, pf[1], O[1][dt], 0, 0, 0);
      }
    }
    if (more) {
      char* nb = lds + ((kt + 1) & 1) * A_STAGE;
#pragma unroll
      for (int i = 0; i < 2; ++i) {
        *(u32x4*)(nb + ksto + i * 32 * 272) = rk[i];
        *(u32x2*)(nb + vsto + i * 64 * A_VSTR) = (u32x2){rv[i].x, rv[i].y};
        *(u32x2*)(nb + vsto + i * 64 * A_VSTR + 8) = (u32x2){rv[i].z, rv[i].w};
      }
    }
    __syncthreads();
  }
  float l0 = ls[0], l1 = ls[1];
  l0 += shflx(l0, 16, lane); l0 += shflx(l0, 32, lane);
  l1 += shflx(l1, 16, lane); l1 += shflx(l1, 32, lane);
  const float i0 = 1.f / l0, i1 = lam / l1;
  float ss = 0.f;
#pragma unroll
  for (int dt = 0; dt < 8; ++dt) {
    f32x4 o = O[0][dt] * i0 - O[1][dt] * i1;
    O[0][dt] = o;
    ss += o.x * o.x + o.y * o.y + o.z * o.z + o.w * o.w;
  }
  ss += shflx(ss, 16, lane); ss += shflx(ss, 32, lane);
  const float rn = rsqrtf(ss * (1.f / 128.f) + 1e-6f) * (1.f - lam_init);
  bf16_t* pr = WS_PROJ(p) + (size_t)qrow * NP + head * 128 + 4 * fq;
  const float* sg = p.subln_g + l * 128 + 4 * fq;
#pragma unroll
  for (int dt = 0; dt < 8; ++dt) {
    const int dv = dt * 16;
    const u32x2 z2 = *(const u32x2*)(pr + C_ZC + dv);
    const f32x4 g4 = *(const f32x4*)(sg + dv);
    const f32x4 o = O[0][dt];
    const float y0 = o.x * rn * g4.x * siluf_(bf_lo(z2.x)), y1 = o.y * rn * g4.y * siluf_(bf_hi(z2.x));
    const float y2 = o.z * rn * g4.z * siluf_(bf_lo(z2.y)), y3 = o.w * rn * g4.w * siluf_(bf_hi(z2.y));
    u32x2 ov = {pack_bf16(y0, y1), pack_bf16(y2, y3)};
    *(u32x2*)(pr + C_YC + dv) = ov;
  }
}
__device__ __forceinline__ void rwkv_out_token(const Params& p, int l, int row, int lane) {
  bf16_t* pr = WS_PROJ(p) + (size_t)row * NP;
  float yf[8], yb[8], r[8], k[8], v[8], z[8];
  u32x4 raw;
  raw = *(const u32x4*)(pr + C_YSF + lane * 8); UNPACK8(raw, yf);
  raw = *(const u32x4*)(pr + C_YSB + lane * 8); UNPACK8(raw, yb);
  raw = *(const u32x4*)(pr + C_R + lane * 8); UNPACK8(raw, r);
  raw = *(const u32x4*)(pr + C_K + lane * 8); UNPACK8(raw, k);
  raw = *(const u32x4*)(pr + C_V + lane * 8); UNPACK8(raw, v);
  raw = *(const u32x4*)(pr + C_ZA + lane * 8); UNPACK8(raw, z);
  const float* rk = p.r_k + l * 512 + lane * 8;
  const float* gg = p.gn_g + l * 512 + lane * 8;
  const float* gb = p.gn_b + l * 512 + lane * 8;
  float sm = 0.f, bs = 0.f;
#pragma unroll
  for (int e = 0; e < 8; ++e) { yf[e] += yb[e]; sm += yf[e]; bs += r[e] * k[e] * rk[e]; }
  sm = grp8_sum(sm); bs = grp8_sum(bs);
  const float mu = sm * (1.f / 64.f);
  float vs = 0.f;
#pragma unroll
  for (int e = 0; e < 8; ++e) { yf[e] -= mu; vs += yf[e] * yf[e]; }
  vs = grp8_sum(vs);
  const float rs = rsqrtf(vs * (1.f / 64.f) + 64e-5f);
  float o[8];
#pragma unroll
  for (int e = 0; e < 8; ++e) o[e] = (yf[e] * rs * gg[e] + gb[e] + bs * v[e]) * siluf_(z[e]);
  *(u32x4*)(pr + C_YA + lane * 8) = PACK8(o);
}
__device__ void phase_attn(const Params& p, int l, char* lds) {
  const int tid0 = opaque_tid();
  const int lane = tid0 & 63;
  const float lam_init = __int_as_float(__builtin_amdgcn_readfirstlane(__float_as_int(0.8f - 0.6f * __expf(-0.3f * (float)l))));
  const float* lq = p.lambda_qk + l * 256;
  float a1 = lq[lane] * lq[64 + lane], a2 = lq[128 + lane] * lq[192 + lane];
  a1 = wave_sum(a1); a2 = wave_sum(a2);
  const float lam = __int_as_float(__builtin_amdgcn_readfirstlane(__float_as_int(__expf(a1) - __expf(a2) + lam_init)));
  const float* qg = p.qk_norm_g + l * 128;
  float mq = fabsf(qg[lane]), mk = fabsf(qg[64 + lane]);
  mq = wave_max(mq); mk = wave_max(mk);
  const float bound2 = __int_as_float(__builtin_amdgcn_readfirstlane(__float_as_int(8.f * mq * mk * 1.44269504f * 1.02f + 0.1f)));
  const int nunit = (l < NL - 1) ? 1088 : 1024;
  for (int u = blockIdx.x; u < nunit; u += gridDim.x) {
    int b, head, q0, nkt;
    if (u < 1024) {
      const int xcd = u & 7, j = u >> 3, pair = xcd + 8 * (j >> 5), qb = j & 31;
      head = pair & 3; b = pair >> 2; q0 = CTX + qb * 128; nkt = S / 64;
    } else {
      const int v = u - 1024; head = (v >> 1) & 3; b = v >> 3; q0 = (v & 1) * 128; nkt = CTX / 64;
    }
    attn_unit(p, l, b, head, q0, nkt, lam, lam_init, bound2, lds);
  }
  const int tid1 = opaque_tid();
  const int gw = blockIdx.x * 8 + (tid1 >> 6), nw = gridDim.x * 8;
  for (int row = gw; row < M; row += nw) rwkv_out_token(p, l, row, tid1 & 63);
}

__device__ void phase_merge1(const Params& p, int l, char* lds) {
  const int tid = opaque_tid(), lane = tid & 63, wid = tid >> 6, wm = wid >> 1, wn = wid & 1, fr = lane & 15, fq = lane >> 4;
  const int xcd = blockIdx.x & 7, bi = blockIdx.x >> 3, nbx = (gridDim.x + 7 - xcd) >> 3;
  for (int idx = bi; idx < 17 * 8; idx += nbx) {
    const int mt = 17 * xcd + (idx >> 3), nt = idx & 7;
    if (l == NL - 1 && (mt % 17) == 0) continue;
    u32x2 macc[4][4];
#pragma unroll
    for (int mi = 0; mi < 4; ++mi)
#pragma unroll
      for (int ni = 0; ni < 4; ++ni) macc[mi][ni] = (u32x2){0u, 0u};
#pragma unroll 1
    for (int i = 0; i < 3; ++i) {
      const int ycol = i == 0 ? C_YA : (i == 1 ? C_YB : C_YC);
      f32x4 acc[4][4];
#pragma unroll
      for (int mi = 0; mi < 4; ++mi)
#pragma unroll
        for (int ni = 0; ni < 4; ++ni) acc[mi][ni] = (f32x4){0.f, 0.f, 0.f, 0.f};
      gemm_256x128_dma(WS_PROJ(p) + (size_t)mt * 256 * NP + ycol, NP, WS_WB(p) + (size_t)(l & 1) * WSET + ((size_t)i * D + nt * 128) * 512, 512, 512, acc, lds, tid);
      u32x2 br[4][4];
#pragma unroll
      for (int mi = 0; mi < 4; ++mi)
#pragma unroll
        for (int ni = 0; ni < 4; ++ni) {
          const f32x4 av = mfma_guard(acc[mi][ni]);
          br[mi][ni] = (u32x2){pack_bf16(av.x, av.y), pack_bf16(av.z, av.w)};
          acc[mi][ni] = (f32x4){0.f, 0.f, 0.f, 0.f};
        }
      gemm_256x128_dma(WS_H(p) + (size_t)mt * 256 * D, D, WS_WG(p) + (size_t)(l & 1) * WSET + ((size_t)i * D + nt * 128) * D, D, D, acc, lds, tid);
#pragma unroll
      for (int mi = 0; mi < 4; ++mi)
#pragma unroll
        for (int ni = 0; ni < 4; ++ni) {
          const f32x4 a = acc[mi][ni];
          const u32x2 bb = br[mi][ni], mm = macc[mi][ni];
          const float m0 = bf_lo(mm.x) + sigmoidf_(a.x) * bf_lo(bb.x), m1 = bf_hi(mm.x) + sigmoidf_(a.y) * bf_hi(bb.x);
          const float m2 = bf_lo(mm.y) + sigmoidf_(a.z) * bf_lo(bb.y), m3 = bf_hi(mm.y) + sigmoidf_(a.w) * bf_hi(bb.y);
          macc[mi][ni] = (u32x2){pack_bf16(m0, m1), pack_bf16(m2, m3)};
        }
    }
#pragma unroll
    for (int mi = 0; mi < 4; ++mi) {
      const int row = mt * 256 + wm * 64 + mi * 16 + fr;
#pragma unroll
      for (int ni = 0; ni < 4; ++ni) {
        const int col = nt * 128 + wn * 64 + ni * 16 + 4 * fq;
        *(u32x2*)(WS_PROJ(p) + (size_t)row * NP + ((nt < 4) ? C_M0 : (C_M1 - 512)) + col) = macc[mi][ni];
      }
    }
  }
}

__device__ void phase_merge2(const Params& p, int l, char* lds) {
  const int tid = opaque_tid(), lane = tid & 63, wid = tid >> 6, wm = wid >> 1, wn = wid & 1, fr = lane & 15, fq = lane >> 4;
  const int xcd = blockIdx.x & 7, bi = blockIdx.x >> 3, nbx = (gridDim.x + 7 - xcd) >> 3;
  for (int idx = bi; idx < 17 * 8; idx += nbx) {
    const int mt = 17 * xcd + (idx >> 3), nt = idx & 7;
    const bool isctx = (mt % 17) == 0;
    if (l == NL - 1 && isctx) continue;
    f32x4 acc[4][4];
#pragma unroll
    for (int mi = 0; mi < 4; ++mi)
#pragma unroll
      for (int ni = 0; ni < 4; ++ni) acc[mi][ni] = (f32x4){0.f, 0.f, 0.f, 0.f};
    gemm_256x128_dma(WS_PROJ(p) + (size_t)mt * 256 * NP + C_M0, NP, WS_WO(p) + (size_t)(l & 1) * WSET + (size_t)nt * 128 * D, D, D, acc, lds, tid, 8,
                     (C_M1 - C_M0 - 512) * 2);
    const int b = mt / 17;
    const float* gate = WS_MOD(p) + ((size_t)l * 9 + (isctx ? 8 : b)) * 3072 + 2048;
#pragma unroll
    for (int mi = 0; mi < 4; ++mi) {
      const int row = mt * 256 + wm * 64 + mi * 16 + fr, s = row - b * S;
      const float* xs = xrow_src(p, l, b, s);
      float* xd = isctx ? (WS_CTXS(p) + ((size_t)b * CTX + s) * D) : (p.out + ((size_t)b * T + (s - CTX)) * D);
#pragma unroll
      for (int ni = 0; ni < 4; ++ni) {
        const int col = nt * 128 + wn * 64 + ni * 16 + 4 * fq;
        const f32x4 g = *(const f32x4*)(gate + col);
        const f32x4 xv = *(const f32x4*)(xs + col);
        *(f32x4*)(xd + col) = xv + g * acc[mi][ni];
      }
    }
  }
}

#ifndef MULTI_LAUNCH
#define MULTI_LAUNCH 0
#endif
#ifndef DUMP_STAGE
#define DUMP_STAGE 0
#define NL_RUN 4
#define PROBE_MEMSET 1
#endif
#if !MULTI_LAUNCH && !DUMP_STAGE
__device__ __forceinline__ void l2_refresh(const Params& p, unsigned seq) {
  const float* base = (seq & 1u) ? p.x : p.w_in;
  const f32x4* src = (const f32x4*)(base + (size_t)blockIdx.x * 131072) + threadIdx.x;
  f32x4 a = {0.f, 0.f, 0.f, 0.f};
#pragma unroll 4
  for (int i = 0; i < 64; ++i) a += src[i * NTHR];
  asm volatile("" ::"v"(a.x), "v"(a.y), "v"(a.z), "v"(a.w));
}

__device__ __forceinline__ void grid_barrier(unsigned* bar, unsigned target) {
  asm volatile("s_waitcnt vmcnt(0) lgkmcnt(0)" ::: "memory");
  __syncthreads();
  if (threadIdx.x == 0) {
    __builtin_amdgcn_fence(__ATOMIC_RELEASE, "");
    asm volatile("s_waitcnt vmcnt(0)" ::: "memory");
    __hip_atomic_fetch_add(bar, 1u, __ATOMIC_RELAXED, __HIP_MEMORY_SCOPE_AGENT);
    while ((int)(__hip_atomic_load(bar, __ATOMIC_RELAXED, __HIP_MEMORY_SCOPE_AGENT) - target) < 0) __builtin_amdgcn_s_sleep(2);
    __builtin_amdgcn_fence(__ATOMIC_ACQUIRE, "");
    asm volatile("s_waitcnt vmcnt(0)" ::: "memory");
  }
  __syncthreads();
}

__device__ void phase_dump(const Params& p, int what) {
  const size_t n = (size_t)NB * T * D;
  for (size_t i = blockIdx.x * (size_t)NTHR + threadIdx.x; i < n; i += (size_t)gridDim.x * NTHR) {
    float v = 0.f;
    if (what == 1) { const int rr = (int)(i / D) % S; v = bf_lo(WS_H(p)[i]); (void)rr; }
    else if (what == 7) v = bf_lo(WS_WG(p)[i % ((size_t)3072 * D)]) + bf_lo(WS_WB(p)[i % ((size_t)1536 * D)]) + bf_lo(WS_WO(p)[i % ((size_t)D * D)]);
    else if (what == 6) { const unsigned* q = (const unsigned*)(WS_PROJ(p) + i * 6);
      for (int j = 0; j < 3; ++j) { unsigned w = __hip_atomic_load(q + j, __ATOMIC_RELAXED, __HIP_MEMORY_SCOPE_AGENT); v += bf_lo(w) + bf_hi(w); } }
    else { for (int j = 0; j < 6; ++j) v += bf_lo(WS_PROJ(p)[i * 6 + j]); if (what == 3) v += bf_lo(WS_VT(p)[i % ((size_t)NB * 4 * 128 * S)]); }
    p.out[i] = v;
  }
}
#ifndef PROBE_TWICE
#define PROBE_TWICE 0
#endif
#ifndef MK_DUMP
#define MK_DUMP 0
#define MK_DUMP_L 0
#endif
__global__ void __launch_bounds__(NTHR) fwd_megakernel(Params p, int l0, int l1) {
  __shared__ __attribute__((aligned(16))) char lds[LDS_BYTES];
  cg::grid_group grid = cg::this_grid();
  unsigned nbar = __builtin_amdgcn_readfirstlane(__hip_atomic_load(WS_BAR(p), __ATOMIC_RELAXED, __HIP_MEMORY_SCOPE_AGENT));
  grid.sync();
  const unsigned nblk = gridDim.x;
#define NL_MK 2
  unsigned nflush = 0;
#define GSYNC() do { nbar += nblk; grid_barrier(WS_BAR(p), nbar); } while (0)
#define GSYNC_REFRESH() do { nbar += nblk; grid_barrier(WS_BAR(p), nbar); l2_refresh(p, nflush++); nbar += nblk; grid_barrier(WS_BAR(p), nbar); } while (0)
  if (l0 == 0) { phase_mod(p, lds); GSYNC(); }
  for (int l = l0; l < l1; ++l) {
    if (MK_DUMP == 8 && l == MK_DUMP_L) return;
    phase_norm(p, l);
    if (l == l0) phase_cvt(p, l, lds, blockIdx.x, gridDim.x);
    GSYNC();
    if (MK_DUMP == 1 && l == MK_DUMP_L) { phase_dump(p, 1); return; }
    if (MK_DUMP == 7 && l == MK_DUMP_L) { phase_dump(p, 7); return; }
    phase_inproj(p, l, lds);
#if PROBE_TWICE == 1
    GSYNC(); phase_inproj(p, l, lds);
#endif
    GSYNC();
    if (MK_DUMP == 2 && l == MK_DUMP_L) { phase_dump(p, 2); return; }
    phase_prep(p, l, lds);
    GSYNC();
    if (MK_DUMP == 3 && l == MK_DUMP_L) { phase_dump(p, 3); return; }
    phase_scan(p, l, lds);
#if PROBE_TWICE == 2
    GSYNC(); phase_scan(p, l, lds);
#endif
    GSYNC_REFRESH();
    if (MK_DUMP == 4 && l == MK_DUMP_L) { phase_dump(p, 4); return; }
    phase_attn(p, l, lds);
    GSYNC();
    if (MK_DUMP == 5 && l == MK_DUMP_L) { phase_dump(p, 5); return; }
    phase_merge1(p, l, lds);
#if PROBE_TWICE == 3
    GSYNC(); phase_merge1(p, l, lds);
#endif
    GSYNC();
    if (MK_DUMP == 6 && l == MK_DUMP_L) { phase_dump(p, 6); return; }
    phase_merge2(p, l, lds);
    if (l + 1 < l1) {
      if (gridDim.x == 256) { const int bi = blockIdx.x >> 3; if (bi >= 8) phase_cvt(p, l + 1, lds, (bi - 8) * 8 + (blockIdx.x & 7), 192); }
      else phase_cvt(p, l + 1, lds, blockIdx.x, gridDim.x);
    }
    if (l + 1 < l1) GSYNC_REFRESH();
  }
}
#endif
#if MULTI_LAUNCH || DUMP_STAGE
__global__ void __launch_bounds__(NTHR) phase_kernel(Params p, int phase, int l) {
  __shared__ __attribute__((aligned(16))) char lds[LDS_BYTES];
  switch (phase) {
    case 0: phase_mod(p, lds); break;
    case 1: phase_norm(p, l); phase_cvt(p, l, lds, blockIdx.x, gridDim.x); break;
    case 2: phase_inproj(p, l, lds); break;
    case 3: phase_prep(p, l, lds); break;
    case 4: phase_scan(p, l, lds); break;
    case 5: phase_attn(p, l, lds); break;
    case 6: phase_merge1(p, l, lds); break;
    default: phase_merge2(p, l, lds); break;
  }
}

__global__ void dump_kernel(Params p, int stage, int n) {
  for (size_t i = blockIdx.x * (size_t)blockDim.x + threadIdx.x; i < (size_t)n; i += (size_t)gridDim.x * blockDim.x) {
    float v = 0.f;
    if (stage == 1) v = WS_MOD(p)[i % (NL * 9 * 3072)];
    else if (stage == 2) v = bf_lo(WS_H(p)[i]);
    else if (stage == 3) v = bf_lo(WS_WIN(p)[i % ((size_t)NP * D)]) + bf_lo(WS_WG(p)[i % ((size_t)3072 * D)]) + bf_lo(WS_WB(p)[i % ((size_t)1536 * D)]) + bf_lo(WS_WO(p)[i % ((size_t)D * D)]);
    else if (stage == 4 || stage == 5) { for (int j = 0; j < 6; ++j) v += bf_lo(WS_PROJ(p)[i * 6 + j]); if (stage == 5) v += bf_lo(WS_VT(p)[i % ((size_t)NB * 4 * 128 * S)]); }
    p.out[i] = v;
  }
}
#endif

extern "C" void kernel_launch(void* const* d_in, const int* in_sizes, int n_in, void* d_out, int out_size, void* d_ws, size_t ws_size,
                              hipStream_t stream) {
  static int grid_blocks = 0;
#if !MULTI_LAUNCH && !DUMP_STAGE
  if (!grid_blocks) {
    int dev = 0, cus = 0, per_cu = 0;
    hipGetDevice(&dev);
    hipDeviceGetAttribute(&cus, hipDeviceAttributeMultiprocessorCount, dev);
    hipOccupancyMaxActiveBlocksPerMultiprocessor(&per_cu, fwd_megakernel, NTHR, 0);
    if (per_cu < 1) per_cu = 1;
    grid_blocks = cus * per_cu;
  }
#endif
  Params p{};
  const float** f = (const float**)&p;
  for (int i = 0; i < 24; ++i) f[i] = (const float*)d_in[i];
  p.out = (float*)d_out;
  p.ws = (char*)d_ws;
  const size_t off = WS_TOTAL;
  if (off > ws_size) { fprintf(stderr, "workspace too small: need %zu have %zu\n", off, ws_size); return; }
  hipMemsetAsync(WS_BAR(p), 0, 256, stream);
#if DUMP_STAGE
  {
    const int maxph = DUMP_STAGE == 1 ? 0 : (DUMP_STAGE <= 3 ? 1 : (DUMP_STAGE == 4 ? 2 : 3));
    for (int ph = 0; ph <= maxph; ++ph) phase_kernel<<<dim3(256), dim3(NTHR), 0, stream>>>(p, ph, 0);
    dump_kernel<<<dim3(1024), dim3(256), 0, stream>>>(p, DUMP_STAGE, out_size);
    return;
  }
#endif
#if MULTI_LAUNCH
  phase_kernel<<<dim3(256), dim3(NTHR), 0, stream>>>(p, 0, 0);
  for (int l = 0; l < NL_RUN; ++l)
    for (int ph = 1; ph <= 7; ++ph) {
#ifdef SKIP_SCAN
      if (ph == 4) continue;
#endif
#ifdef SKIP_ATTN
      if (ph == 5) continue;
#endif
      phase_kernel<<<dim3(256), dim3(NTHR), 0, stream>>>(p, ph, l);
    }
  return;
#endif
#if !MULTI_LAUNCH && !DUMP_STAGE
#ifndef LAYERS_PER_LAUNCH
#define LAYERS_PER_LAUNCH 4
#endif
  for (int l0 = 0; l0 < (MK_DUMP ? MK_DUMP_L + 1 : NL); l0 += LAYERS_PER_LAUNCH) {
    int a0 = l0, a1 = l0 + LAYERS_PER_LAUNCH;
    void* args[] = {&p, &a0, &a1};
    hipError_t e = hipLaunchCooperativeKernel((void*)fwd_megakernel, dim3(grid_blocks), dim3(NTHR), args, 0, stream);
    if (e != hipSuccess) fprintf(stderr, "cooperative launch failed: %s (grid %d)\n", hipGetErrorString(e), grid_blocks);
  }
#endif
}
```

```cpp
#include <hip/hip_runtime.h>
#include <hip/hip_cooperative_groups.h>
#include <cstdio>
#include <cstdint>
namespace cg = cooperative_groups;

typedef unsigned short bf16_t;
typedef short bf16x8 __attribute__((ext_vector_type(8)));
typedef float f32x4 __attribute__((ext_vector_type(4)));
typedef float f32x2 __attribute__((ext_vector_type(2)));
typedef unsigned u32x4 __attribute__((ext_vector_type(4)));
typedef unsigned u32x2 __attribute__((ext_vector_type(2)));

constexpr int D = 1024, NB = 8, T = 4096, NL = 4, CTX = 256, S = T + CTX, M = NB * S, NP = 6400, NIN = 9472;
constexpr int C_R = 0, C_K = 512, C_V = 1024, C_LWF = 1536, C_LWB = 1600, C_LAF = 1664, C_LAB = 1728, C_ZA = 1792,
              C_GB = 2304, C_GC = 2816, C_U = 3328, C_ZB = 3840, C_QD = 4352, C_KD = 4864, C_VD = 5376, C_ZC = 5888;
constexpr int C_YA = C_R, C_YB = C_GB, C_YC = C_QD, C_M0 = C_ZB, C_M1 = C_VD, C_YSF = C_GC, C_YSB = C_U, C_KK = C_ZB;
constexpr int NTHR = 512;
constexpr size_t WSET = (size_t)NP * D + (size_t)3072 * D + (size_t)3 * D * 512 + (size_t)D * D;
constexpr int LDS_BYTES = 147456;

struct Params {
  const float *x, *c, *ctx, *c_ctx, *w_mod, *b_mod, *norm_g, *w_in, *decay_w0, *decay_up, *iclr_a0, *iclr_up, *k_k, *k_a, *r_k,
      *gn_g, *gn_b, *conv_w, *conv_b, *qk_norm_g, *lambda_qk, *subln_g, *w_branch, *w_out;
  float* out;
  char* ws;
};
constexpr size_t al256(size_t x) { return (x + 255) & ~(size_t)255; }
constexpr size_t WSET_C = (size_t)NP * D + (size_t)3072 * D + (size_t)3 * D * 512 + (size_t)D * D;
constexpr size_t OFF_PROJ = 0;
constexpr size_t OFF_H = OFF_PROJ + al256((size_t)M * NP * 2);
constexpr size_t OFF_VT = OFF_H + al256((size_t)M * D * 2);
constexpr size_t OFF_W = OFF_VT + al256((size_t)NB * 4 * 128 * S * 2);
constexpr size_t OFF_CTXS = OFF_W + al256(2 * WSET_C * 2);
constexpr size_t OFF_MOD = OFF_CTXS + al256((size_t)NB * CTX * D * 4);
constexpr size_t OFF_BAR = OFF_MOD + al256((size_t)NL * 9 * 3072 * 4);
constexpr size_t WS_TOTAL = OFF_BAR + 256;
#define WS_PROJ(p) ((bf16_t*)((p).ws + OFF_PROJ))
#define WS_H(p) ((bf16_t*)((p).ws + OFF_H))
#define WS_VT(p) ((bf16_t*)((p).ws + OFF_VT))
#define WS_WIN(p) ((bf16_t*)((p).ws + OFF_W))
#define WS_WG(p) (WS_WIN(p) + (size_t)NP * D)
#define WS_WB(p) (WS_WG(p) + (size_t)3072 * D)
#define WS_WO(p) (WS_WB(p) + (size_t)3 * D * 512)
#define WS_CTXS(p) ((float*)((p).ws + OFF_CTXS))
#define WS_MOD(p) ((float*)((p).ws + OFF_MOD))
#define WS_BAR(p) ((unsigned*)((p).ws + OFF_BAR))

__device__ __forceinline__ int opaque_tid() { int t = threadIdx.x; asm volatile("" : "+v"(t)); return t; }
__device__ __forceinline__ float bf_lo(unsigned u) { return __uint_as_float(u << 16); }
__device__ __forceinline__ float bf_hi(unsigned u) { return __uint_as_float(u & 0xffff0000u); }
__device__ __forceinline__ unsigned pack_bf16(float lo, float hi) {
  unsigned r;
  asm("s_nop 0\n\tv_cvt_pk_bf16_f32 %0, %1, %2" : "=v"(r) : "v"(lo), "v"(hi));
  return r;
}
__device__ __forceinline__ float vmul_(float a, float b) { float d; asm("v_mul_f32 %0, %1, %2" : "=v"(d) : "v"(a), "v"(b)); return d; }
__device__ __forceinline__ float vfma_(float a, float b, float c) { float d; asm("v_fma_f32 %0, %1, %2, %3" : "=v"(d) : "v"(a), "v"(b), "v"(c)); return d; }
__device__ __forceinline__ float vfnma_(float a, float b, float c) { float d; asm("v_fma_f32 %0, -%1, %2, %3" : "=v"(d) : "v"(a), "v"(b), "v"(c)); return d; }
typedef __bf16 bf16v2_t __attribute__((ext_vector_type(2)));
__device__ __forceinline__ unsigned pack_bf16_b(float lo, float hi) {
  const f32x2 v = {lo, hi};
  return __builtin_bit_cast(unsigned, __builtin_convertvector(v, bf16v2_t));
}
__device__ __forceinline__ f32x4 mfma_guard(f32x4 v) { return v + (f32x4){0.f, 0.f, 0.f, 0.f}; }
__device__ __forceinline__ float sigmoidf_(float x) { return __builtin_amdgcn_rcpf(1.f + __expf(-x)); }
__device__ __forceinline__ float siluf_(float x) { return x * sigmoidf_(x); }
__device__ __forceinline__ float tanhf_(float x) { return 1.f - 2.f * __builtin_amdgcn_rcpf(__expf(2.f * x) + 1.f); }
template <int CTRL> __device__ __forceinline__ float dppf(float x) {
  return __int_as_float(__builtin_amdgcn_update_dpp(0, __float_as_int(x), CTRL, 0xF, 0xF, true));
}
__device__ __forceinline__ float allreduce8(float x) {
  x += dppf<0xB1>(x);
  x += dppf<0x4E>(x);
  x += dppf<0x141>(x);
  return x;
}
__device__ __forceinline__ float grp8_sum(float v) { return allreduce8(v); }
__device__ __forceinline__ float wave_sum(float v) {
  v = allreduce8(v);
  v += dppf<0x140>(v);
  return __int_as_float(__builtin_amdgcn_readlane(__float_as_int(v), 0)) + __int_as_float(__builtin_amdgcn_readlane(__float_as_int(v), 16)) +
         __int_as_float(__builtin_amdgcn_readlane(__float_as_int(v), 32)) + __int_as_float(__builtin_amdgcn_readlane(__float_as_int(v), 48));
}
__device__ __forceinline__ float wave_max(float v) {
  v = fmaxf(v, dppf<0xB1>(v));
  v = fmaxf(v, dppf<0x4E>(v));
  v = fmaxf(v, dppf<0x141>(v));
  v = fmaxf(v, dppf<0x140>(v));
  return fmaxf(fmaxf(__int_as_float(__builtin_amdgcn_readlane(__float_as_int(v), 0)), __int_as_float(__builtin_amdgcn_readlane(__float_as_int(v), 16))),
               fmaxf(__int_as_float(__builtin_amdgcn_readlane(__float_as_int(v), 32)), __int_as_float(__builtin_amdgcn_readlane(__float_as_int(v), 48))));
}
__device__ __forceinline__ float shflx(float v, int mask, int lane) {
  return __int_as_float(__builtin_amdgcn_ds_bpermute((lane ^ mask) << 2, __float_as_int(v)));
}
#define UNPACK8(raw, f)                                                                                  \
  {                                                                                                      \
    f[0] = bf_lo(raw.x); f[1] = bf_hi(raw.x); f[2] = bf_lo(raw.y); f[3] = bf_hi(raw.y);                  \
    f[4] = bf_lo(raw.z); f[5] = bf_hi(raw.z); f[6] = bf_lo(raw.w); f[7] = bf_hi(raw.w);                  \
  }
#define PACK8(f) ((u32x4){pack_bf16(f[0], f[1]), pack_bf16(f[2], f[3]), pack_bf16(f[4], f[5]), pack_bf16(f[6], f[7])})

constexpr int G_STAGE = 55296, G_BOFF = 36864;
__device__ __forceinline__ void gemm_256x128(const bf16_t* A, int lda, const bf16_t* Bt, int ldb, int K,
                                             f32x4 (&acc)[4][4], char* lds, const int tid) {
  const int lane = tid & 63, wid = tid >> 6, wm = wid >> 1, wn = wid & 1, fr = lane & 15, fq = lane >> 4;
  const int srow = tid >> 3, sch = tid & 7;
  const bf16_t* ag = A + (size_t)srow * lda + sch * 8;
  const bf16_t* bg = Bt + (size_t)srow * ldb + sch * 8;
  u32x4 ra[4], rb[2];
  const int nk = K >> 6;
#pragma unroll
  for (int i = 0; i < 4; ++i) ra[i] = *(const u32x4*)(ag + (size_t)(64 * i) * lda);
#pragma unroll
  for (int i = 0; i < 2; ++i) rb[i] = *(const u32x4*)(bg + (size_t)(64 * i) * ldb);
#pragma unroll
  for (int i = 0; i < 4; ++i) *(u32x4*)(lds + (srow + 64 * i) * 144 + sch * 16) = ra[i];
#pragma unroll
  for (int i = 0; i < 2; ++i) *(u32x4*)(lds + G_BOFF + (srow + 64 * i) * 144 + sch * 16) = rb[i];
  __syncthreads();
  for (int kt = 0; kt < nk; ++kt) {
    const bool more = (kt + 1 < nk);
    if (more) {
#pragma unroll
      for (int i = 0; i < 4; ++i) ra[i] = *(const u32x4*)(ag + (size_t)(64 * i) * lda + (kt + 1) * 64);
#pragma unroll
      for (int i = 0; i < 2; ++i) rb[i] = *(const u32x4*)(bg + (size_t)(64 * i) * ldb + (kt + 1) * 64);
    }
    const char* base = lds + (kt & 1) * G_STAGE;
#pragma unroll
    for (int ks = 0; ks < 2; ++ks) {
      bf16x8 af[4], bfr[4];
#pragma unroll
      for (int mi = 0; mi < 4; ++mi) af[mi] = *(const bf16x8*)(base + (wm * 64 + mi * 16 + fr) * 144 + ks * 64 + fq * 16);
#pragma unroll
      for (int ni = 0; ni < 4; ++ni) bfr[ni] = *(const bf16x8*)(base + G_BOFF + (wn * 64 + ni * 16 + fr) * 144 + ks * 64 + fq * 16);
#pragma unroll
      for (int mi = 0; mi < 4; ++mi)
#pragma unroll
        for (int ni = 0; ni < 4; ++ni) acc[mi][ni] = __builtin_amdgcn_mfma_f32_16x16x32_bf16(bfr[ni], af[mi], acc[mi][ni], 0, 0, 0);
    }
    if (more) {
      char* nb = lds + ((kt + 1) & 1) * G_STAGE;
#pragma unroll
      for (int i = 0; i < 4; ++i) *(u32x4*)(nb + (srow + 64 * i) * 144 + sch * 16) = ra[i];
#pragma unroll
      for (int i = 0; i < 2; ++i) *(u32x4*)(nb + G_BOFF + (srow + 64 * i) * 144 + sch * 16) = rb[i];
    }
    __syncthreads();
  }
}

__device__ __forceinline__ void gemm_256x128_deep(const bf16_t* A, int lda, const bf16_t* Bt, int ldb, int K, f32x4 (&acc)[4][4], char* lds,
                                                  const int tid) {
  const int lane = tid & 63, wid = tid >> 6, wm = wid >> 1, wn = wid & 1, fr = lane & 15, fq = lane >> 4;
  const int srow = tid >> 3, sch = tid & 7;
  const bf16_t* ag = A + (size_t)srow * lda + sch * 8;
  const bf16_t* bg = Bt + (size_t)srow * ldb + sch * 8;
  u32x4 ra0[4], rb0[2], ra1[4], rb1[2];
  const int nk = K >> 6;
#define GLOAD(RA, RB, kt_)                                                                                  \
  {                                                                                                         \
    _Pragma("unroll") for (int i = 0; i < 4; ++i) RA[i] = *(const u32x4*)(ag + (size_t)(64 * i) * lda + (kt_) * 64); \
    _Pragma("unroll") for (int i = 0; i < 2; ++i) RB[i] = *(const u32x4*)(bg + (size_t)(64 * i) * ldb + (kt_) * 64); \
  }
#define LSTORE(RA, RB, st_)                                                                                 \
  {                                                                                                         \
    char* nb_ = lds + (st_) * G_STAGE;                                                                      \
    _Pragma("unroll") for (int i = 0; i < 4; ++i) *(u32x4*)(nb_ + (srow + 64 * i) * 144 + sch * 16) = RA[i]; \
    _Pragma("unroll") for (int i = 0; i < 2; ++i) *(u32x4*)(nb_ + G_BOFF + (srow + 64 * i) * 144 + sch * 16) = RB[i]; \
  }
#define GCOMPUTE(st_)                                                                                       \
  {                                                                                                         \
    const char* base_ = lds + (st_) * G_STAGE;                                                              \
    _Pragma("unroll") for (int ks = 0; ks < 2; ++ks) {                                                      \
      bf16x8 af[4], bfr[4];                                                                                 \
      _Pragma("unroll") for (int mi = 0; mi < 4; ++mi) af[mi] = *(const bf16x8*)(base_ + (wm * 64 + mi * 16 + fr) * 144 + ks * 64 + fq * 16); \
      _Pragma("unroll") for (int ni = 0; ni < 4; ++ni) bfr[ni] = *(const bf16x8*)(base_ + G_BOFF + (wn * 64 + ni * 16 + fr) * 144 + ks * 64 + fq * 16); \
      _Pragma("unroll") for (int mi = 0; mi < 4; ++mi)                                                      \
        _Pragma("unroll") for (int ni = 0; ni < 4; ++ni) acc[mi][ni] = __builtin_amdgcn_mfma_f32_16x16x32_bf16(bfr[ni], af[mi], acc[mi][ni], 0, 0, 0); \
    }                                                                                                       \
  }
  GLOAD(ra0, rb0, 0);
  LSTORE(ra0, rb0, 0);
  GLOAD(ra0, rb0, 1);
  __syncthreads();
#pragma unroll 1
  for (int kt = 0; kt < nk; kt += 2) {
    if (kt + 2 < nk) GLOAD(ra1, rb1, kt + 2);
    GCOMPUTE(0);
    LSTORE(ra0, rb0, 1);
    __syncthreads();
    if (kt + 3 < nk) GLOAD(ra0, rb0, kt + 3);
    GCOMPUTE(1);
    if (kt + 2 < nk) LSTORE(ra1, rb1, 0);
    __syncthreads();
  }
#undef GLOAD
#undef LSTORE
#undef GCOMPUTE
}

#define LAS __attribute__((address_space(3)))
constexpr int D_STAGE = 49152;
__device__ __forceinline__ int dma_lds_byte(int r, int c) {
  const int st = (r >> 4) * 2 + (c >> 5), rr = r & 15, cc = c & 31, ob = rr * 64 + cc * 2;
  return st * 1024 + (ob ^ (((ob >> 9) & 1) << 5));
}
__device__ __forceinline__ void dma_stage_rc(int b, int& R, int& C) {
  const int st = b / 1024, sb = b % 1024, swz = sb ^ (((sb >> 9) & 1) << 5);
  R = (st >> 1) * 16 + swz / 64;
  C = (st & 1) * 32 + (swz % 64) / 2;
}
__device__ __forceinline__ void gemm_256x128_dma(const bf16_t* A, int lda, const bf16_t* Bt, int ldb, int K, f32x4 (&acc)[4][4], char* lds,
                                                 const int tid, const int ksplit = 1 << 30, const int asplit_bytes = 0) {
  const int lane = tid & 63, wid = __builtin_amdgcn_readfirstlane(tid >> 6), wm = wid >> 1, wn = wid & 1, fr = lane & 15, fq = lane >> 4;
  unsigned voffA[2], voffB[2];
#pragma unroll
  for (int i = 0; i < 2; ++i) {
    int R, C;
    dma_stage_rc(tid * 16 + i * 8192, R, C);
    voffA[i] = (unsigned)(R * lda + C) * 2u;
    voffB[i] = (unsigned)(R * ldb + C) * 2u;
  }
  const char* Ab = (const char*)A;
  const char* Bb = (const char*)Bt;
  const size_t ahalf = (size_t)128 * lda * 2;
  LAS char* l3 = (LAS char*)lds;
  const unsigned ldsw = (unsigned)wid * 1024u;
  const int aoff = (wm >> 1) * 16384 + dma_lds_byte((wm & 1) * 64 + fr, fq * 8);
  const int boff = 32768 + dma_lds_byte(wn * 64 + fr, fq * 8);
  const int nk = K >> 6;
#define DMA_STAGE(kt_, sbase_)                                                                                               \
  {                                                                                                                          \
    const char* ga_ = Ab + (size_t)(kt_) * 128 + ((kt_) >= ksplit ? asplit_bytes : 0);                                                                              \
    const char* gb_ = Bb + (size_t)(kt_) * 128;                                                                              \
    _Pragma("unroll") for (int i_ = 0; i_ < 2; ++i_) {                                                                       \
      __builtin_amdgcn_global_load_lds((const unsigned*)(ga_ + voffA[i_]), (LAS unsigned*)(l3 + (sbase_) + ldsw + i_ * 8192), 16, 0, 0);          \
      __builtin_amdgcn_global_load_lds((const unsigned*)(ga_ + ahalf + voffA[i_]), (LAS unsigned*)(l3 + (sbase_) + 16384 + ldsw + i_ * 8192), 16, 0, 0); \
      __builtin_amdgcn_global_load_lds((const unsigned*)(gb_ + voffB[i_]), (LAS unsigned*)(l3 + (sbase_) + 32768 + ldsw + i_ * 8192), 16, 0, 0);  \
    }                                                                                                                        \
  }
  asm volatile("s_waitcnt vmcnt(0)" ::: "memory");
  DMA_STAGE(0, 0);
  DMA_STAGE(1, D_STAGE);
  asm volatile("s_waitcnt vmcnt(6)" ::: "memory");
  __builtin_amdgcn_s_barrier();
  int sc = 0, sn = 2 * D_STAGE;
#pragma unroll 1
  for (int kt = 0; kt < nk; ++kt) {
    const bool pre = kt + 2 < nk;
    if (pre) DMA_STAGE(kt + 2, sn);
    {
      const LAS char* base = l3 + sc;
#pragma unroll
      for (int ks = 0; ks < 2; ++ks) {
        bf16x8 af[4], bfr[4];
#pragma unroll
        for (int mi = 0; mi < 4; ++mi) af[mi] = *(const LAS bf16x8*)(base + aoff + mi * 2048 + ks * 1024);
#pragma unroll
        for (int ni = 0; ni < 4; ++ni) bfr[ni] = *(const LAS bf16x8*)(base + boff + ni * 2048 + ks * 1024);
        __builtin_amdgcn_sched_barrier(0);
#pragma unroll
        for (int mi = 0; mi < 4; ++mi)
#pragma unroll
          for (int ni = 0; ni < 4; ++ni) acc[mi][ni] = __builtin_amdgcn_mfma_f32_16x16x32_bf16(bfr[ni], af[mi], acc[mi][ni], 0, 0, 0);
      }
    }
    if (pre) asm volatile("s_waitcnt vmcnt(6)" ::: "memory");
    else asm volatile("s_waitcnt vmcnt(0)" ::: "memory");
    __builtin_amdgcn_s_barrier();
    sc = (sc == 2 * D_STAGE) ? 0 : sc + D_STAGE;
    sn = (sn == 2 * D_STAGE) ? 0 : sn + D_STAGE;
  }
#undef DMA_STAGE
}

__device__ __forceinline__ void gemm_256x256_dma(const bf16_t* A, int lda, const bf16_t* Bt, int ldb, int K, f32x4 (&acc)[8][4], char* lds,
                                                 const int tid) {
  const int lane = tid & 63, wid = __builtin_amdgcn_readfirstlane(tid >> 6), wm = wid >> 2, wn = wid & 3, fr = lane & 15, fq = lane >> 4;
  unsigned voffA[2], voffB[2];
#pragma unroll
  for (int i = 0; i < 2; ++i) {
    int R, C;
    dma_stage_rc(tid * 16 + i * 8192, R, C);
    voffA[i] = (unsigned)(R * lda + C) * 2u;
    voffB[i] = (unsigned)(R * ldb + C) * 2u;
  }
  const char* Ab = (const char*)A;
  const char* Bb = (const char*)Bt;
  const size_t ahalf = (size_t)128 * lda * 2, bhalf = (size_t)128 * ldb * 2;
  LAS char* l3 = (LAS char*)lds;
  const unsigned ldsw = (unsigned)wid * 1024u;
  const int aoff = wm * 16384 + dma_lds_byte(fr, fq * 8);
  const int boff = 32768 + (wn >> 1) * 16384 + dma_lds_byte((wn & 1) * 64 + fr, fq * 8);
  const int nk = K >> 6;
#define DMA_STAGE4(kt_, sbase_)                                                                                              \
  {                                                                                                                          \
    const char* ga_ = Ab + (size_t)(kt_) * 128;                                                                              \
    const char* gb_ = Bb + (size_t)(kt_) * 128;                                                                              \
    _Pragma("unroll") for (int i_ = 0; i_ < 2; ++i_) {                                                                       \
      __builtin_amdgcn_global_load_lds((const unsigned*)(ga_ + voffA[i_]), (LAS unsigned*)(l3 + (sbase_) + ldsw + i_ * 8192), 16, 0, 0);          \
      __builtin_amdgcn_global_load_lds((const unsigned*)(ga_ + ahalf + voffA[i_]), (LAS unsigned*)(l3 + (sbase_) + 16384 + ldsw + i_ * 8192), 16, 0, 0); \
      __builtin_amdgcn_global_load_lds((const unsigned*)(gb_ + voffB[i_]), (LAS unsigned*)(l3 + (sbase_) + 32768 + ldsw + i_ * 8192), 16, 0, 0);  \
      __builtin_amdgcn_global_load_lds((const unsigned*)(gb_ + bhalf + voffB[i_]), (LAS unsigned*)(l3 + (sbase_) + 49152 + ldsw + i_ * 8192), 16, 0, 0); \
    }                                                                                                                        \
  }
  asm volatile("s_waitcnt vmcnt(0)" ::: "memory");
  DMA_STAGE4(0, 0);
  asm volatile("s_waitcnt vmcnt(0)" ::: "memory");
  __builtin_amdgcn_s_barrier();
#pragma unroll 1
  for (int kt = 0; kt < nk; ++kt) {
    const int sc = (kt & 1) * 65536;
    if (kt + 1 < nk) DMA_STAGE4(kt + 1, 65536 - sc);
    {
      const LAS char* base = l3 + sc;
#pragma unroll
      for (int ks = 0; ks < 2; ++ks) {
        bf16x8 af[8], bfr[4];
#pragma unroll
        for (int ni = 0; ni < 4; ++ni) bfr[ni] = *(const LAS bf16x8*)(base + boff + ni * 2048 + ks * 1024);
#pragma unroll
        for (int mi = 0; mi < 8; ++mi) af[mi] = *(const LAS bf16x8*)(base + aoff + mi * 2048 + ks * 1024);
        __builtin_amdgcn_sched_barrier(0);
#pragma unroll
        for (int mi = 0; mi < 8; ++mi)
#pragma unroll
          for (int ni = 0; ni < 4; ++ni) acc[mi][ni] = __builtin_amdgcn_mfma_f32_16x16x32_bf16(bfr[ni], af[mi], acc[mi][ni], 0, 0, 0);
      }
    }
    asm volatile("s_waitcnt vmcnt(0)" ::: "memory");
    __builtin_amdgcn_s_barrier();
  }
#undef DMA_STAGE4
}

__device__ void phase_mod(const Params& p, char* lds) {
  const int tid = opaque_tid();
  float* sc = (float*)lds;
  for (int i = tid; i < 9 * 1024; i += NTHR) {
    int s = i >> 10, k = i & 1023;
    float v = s < 8 ? p.c[s * 1024 + k] : p.c_ctx[k];
    sc[i] = siluf_(v);
  }
  __syncthreads();
  float* red = sc + 9 * 1024;
  for (int u = blockIdx.x; u < NL * 48; u += gridDim.x) {
    const int l = u / 48, n0 = (u % 48) * 64, col = tid & 63, kq = tid >> 6;
    const float* w = p.w_mod + (size_t)l * 1024 * 3072 + (size_t)(kq * 128) * 3072 + n0 + col;
    float a[9];
#pragma unroll
    for (int s = 0; s < 9; ++s) a[s] = 0.f;
#pragma unroll 4
    for (int k = 0; k < 128; ++k) {
      float wv = w[(size_t)k * 3072];
#pragma unroll
      for (int s = 0; s < 9; ++s) a[s] += sc[s * 1024 + kq * 128 + k] * wv;
    }
#pragma unroll
    for (int s = 0; s < 9; ++s) red[(kq * 64 + col) * 9 + s] = a[s];
    __syncthreads();
    for (int o = tid; o < 576; o += NTHR) {
      int cc = o / 9, s = o % 9;
      float t = 0.f;
#pragma unroll
      for (int q = 0; q < 8; ++q) t += red[(q * 64 + cc) * 9 + s];
      WS_MOD(p)[((size_t)l * 9 + s) * 3072 + n0 + cc] = t + p.b_mod[l * 3072 + n0 + cc];
    }
    __syncthreads();
  }
}

__device__ __forceinline__ void cvt_tile(const float* src, int ldsrc, bf16_t* dst, int K, int k0, int n0, float* tl, const int tid) {
#pragma unroll
  for (int i = 0; i < 2; ++i) {
    int kk = (tid >> 4) + 32 * i, nn = (tid & 15) * 4;
    f32x4 v = *(const f32x4*)(src + (size_t)(k0 + kk) * ldsrc + n0 + nn);
    tl[kk * 65 + nn + 0] = v.x; tl[kk * 65 + nn + 1] = v.y; tl[kk * 65 + nn + 2] = v.z; tl[kk * 65 + nn + 3] = v.w;
  }
  __syncthreads();
  {
    int n = tid >> 3, k8 = (tid & 7) * 8;
    float f[8];
#pragma unroll
    for (int e = 0; e < 8; ++e) f[e] = tl[(k8 + e) * 65 + n];
    *(u32x4*)(dst + (size_t)(n0 + n) * K + k0 + k8) = PACK8(f);
  }
  __syncthreads();
}
__device__ void phase_cvt(const Params& p, int l, char* lds, int rank, int stride) {
  const int tid = opaque_tid();
  float* tl = (float*)lds;
  const size_t wso = (size_t)(l & 1) * WSET;
  const float* win = p.w_in + (size_t)l * D * NIN;
  const float* wbr = p.w_branch + (size_t)l * 3 * 512 * D;
  const float* wo = p.w_out + (size_t)l * D * D;
  for (int u = rank; u < 3008; u += stride) {
    if (u < 2368) {
      int kt = u / 148, nt = u % 148;
      if (nt < 100) cvt_tile(win, NIN, WS_WIN(p) + wso, D, kt * 64, nt * 64, tl, tid);
      else cvt_tile(win + 6400, NIN, WS_WG(p) + wso, D, kt * 64, (nt - 100) * 64, tl, tid);
    } else if (u < 2368 + 384) {
      int v = u - 2368, i = v / 128, r = v % 128, kt = r / 16, nt = r % 16;
      cvt_tile(wbr + (size_t)i * 512 * D, D, WS_WB(p) + wso + (size_t)i * D * 512, 512, kt * 64, nt * 64, tl, tid);
    } else {
      int v = u - 2752, kt = v / 16, nt = v % 16;
      cvt_tile(wo, D, WS_WO(p) + wso, D, kt * 64, nt * 64, tl, tid);
    }
  }
}

__device__ __forceinline__ const float* xrow_src(const Params& p, int l, int b, int s) {
  return (s < CTX) ? ((l == 0 ? p.ctx : WS_CTXS(p)) + ((size_t)b * CTX + s) * D) : ((l == 0 ? p.x : p.out) + ((size_t)b * T + (s - CTX)) * D);
}
__device__ void phase_norm(const Params& p, int l) {
  const int tid = opaque_tid();
  const int gw = blockIdx.x * 8 + (tid >> 6), nw = gridDim.x * 8, lane = tid & 63;
  const float* ng = p.norm_g + l * D;
  for (int row = gw; row < M; row += nw) {
    const int b = row / S, s = row % S;
    const float* xr = xrow_src(p, l, b, s);
#ifndef PROBE_NORM
#define PROBE_NORM 0
#endif
    const float* md = WS_MOD(p) + ((size_t)(PROBE_NORM == 1 ? 0 : l) * 9 + (s < CTX ? 8 : b)) * 3072;
    f32x4 v[4];
    float ss = 0.f;
#pragma unroll
    for (int i = 0; i < 4; ++i) {
      v[i] = *(const f32x4*)(xr + i * 256 + lane * 4);
      ss += v[i].x * v[i].x + v[i].y * v[i].y + v[i].z * v[i].z + v[i].w * v[i].w;
    }
    ss = wave_sum(ss);
    const float rstd = rsqrtf(ss * (1.f / 1024.f) + 1e-6f);
#pragma unroll
    for (int i = 0; i < 4; ++i) {
      const int col = i * 256 + lane * 4;
      f32x4 g = *(const f32x4*)(ng + col), sh = *(const f32x4*)(md + col), sc = *(const f32x4*)(md + 1024 + col);
      f32x4 y = v[i] * rstd * g * (1.f + sc) + sh;
      u32x2 o = {pack_bf16(y.x, y.y), pack_bf16(y.z, y.w)};
      *(u32x2*)(WS_H(p) + (size_t)row * D + col) = o;
    }
  }
}

__device__ void phase_inproj(const Params& p, int l, char* lds) {
  const int tid = opaque_tid(), lane = tid & 63, wid = tid >> 6, wm = wid >> 2, wn = wid & 3, fr = lane & 15, fq = lane >> 4;
  const int xcd = blockIdx.x & 7, bi = blockIdx.x >> 3, nbx = (gridDim.x + 7 - xcd) >> 3;
  for (int idx = bi; idx < 17 * 25; idx += nbx) {
    int ml, nl, mg, ng;
    if (idx < 400) {
      mg = idx / 100;
      const int rem = idx - mg * 100;
      ng = rem >> 5;
      const int rem2 = rem & 31;
      if (ng < 3) { ml = rem2 & 3; nl = rem2 >> 2; } else { ml = rem2; nl = 0; }
    } else { mg = 4; ng = 0; ml = 0; nl = idx - 400; }
    const int mt = 17 * xcd + mg * 4 + ml, nt = ng * 8 + nl;
    f32x4 acc[8][4];
#pragma unroll
    for (int mi = 0; mi < 8; ++mi)
#pragma unroll
      for (int ni = 0; ni < 4; ++ni) acc[mi][ni] = (f32x4){0.f, 0.f, 0.f, 0.f};
    gemm_256x256_dma(WS_H(p) + (size_t)mt * 256 * D, D, WS_WIN(p) + (size_t)(l & 1) * WSET + (size_t)nt * 256 * D, D, D, acc, lds, tid);
    const bool dotanh = (nt == 6) && (wn < 2);
    char* wl = lds + wid * 18432;
#pragma unroll
    for (int mi = 0; mi < 8; ++mi)
#pragma unroll
      for (int ni = 0; ni < 4; ++ni) {
        f32x4 v = mfma_guard(acc[mi][ni]);
        if (dotanh) { v.x = tanhf_(v.x); v.y = tanhf_(v.y); v.z = tanhf_(v.z); v.w = tanhf_(v.w); }
        const u32x2 o = {pack_bf16(v.x, v.y), pack_bf16(v.z, v.w)};
        *(u32x2*)(wl + (mi * 16 + fr) * 144 + (ni * 16 + 4 * fq) * 2) = o;
      }
    {
      const int rr = lane >> 3, cc = lane & 7;
      bf16_t* gbase = WS_PROJ(p) + (size_t)(mt * 256 + wm * 128) * NP + nt * 256 + wn * 64 + cc * 8;
#pragma unroll
      for (int j = 0; j < 16; ++j) {
        const int r = j * 8 + rr;
        const u32x4 o = *(const u32x4*)(wl + r * 144 + cc * 16);
        *(u32x4*)(gbase + (size_t)r * NP) = o;
      }
    }
    __syncthreads();
  }
}

__device__ __forceinline__ void prep_token(const Params& p, int l, int row, int lane) {
  const int s = row % S;
  const bool lat = s >= CTX;
  const int t = s - CTX;
  bf16_t* pr = WS_PROJ(p) + (size_t)row * NP;
  const int gi = lane & 7, d0 = gi * 8;
  float cs[8], sn[8];
  if (lat) {
    const float pos = (gi >> 2) ? (float)(t & 63) : (float)(t >> 6);
#pragma unroll
    for (int e = 0; e < 8; ++e) {
      float fr_ = __builtin_amdgcn_exp2f(-(float)((gi & 1) * 8 + e) * 0.830482024f);
      float rev = pos * fr_ * 0.15915494309f;
      rev = rev - floorf(rev);
      cs[e] = __builtin_amdgcn_cosf(rev);
      sn[e] = __builtin_amdgcn_sinf(rev);
    }
  } else {
#pragma unroll
    for (int e = 0; e < 8; ++e) { cs[e] = 1.f; sn[e] = 0.f; }
  }
  const float sgn = ((gi >> 1) & 1) ? 1.f : -1.f;
#pragma unroll
  for (int which = 0; which < 2; ++which) {
    bf16_t* ptr = pr + (which ? C_KD : C_QD) + lane * 8;
    const float* g = p.qk_norm_g + l * 128 + which * 64 + d0;
    u32x4 raw = *(const u32x4*)ptr;
    float x[8], y[8];
    UNPACK8(raw, x);
    float ss = 0.f;
#pragma unroll
    for (int e = 0; e < 8; ++e) ss += x[e] * x[e];
    ss = grp8_sum(ss);
    const float rstd = rsqrtf(ss * (1.f / 64.f) + 1e-6f);
    const float osc = which ? 1.f : 0.18033688011f;
#pragma unroll
    for (int e = 0; e < 8; ++e) y[e] = x[e] * rstd * g[e];
#pragma unroll
    for (int e = 0; e < 8; ++e) {
      float pv = dppf<0x4E>(y[e]);
      x[e] = (y[e] * cs[e] + sgn * pv * sn[e]) * osc;
    }
    *(u32x4*)ptr = PACK8(x);
  }
  u32x4 kkp;
  {
    u32x4 raw = *(const u32x4*)(pr + C_K + lane * 8);
    float x[8];
    UNPACK8(raw, x);
    const float* kkw = p.k_k + l * 512 + lane * 8;
    float ss = 0.f;
#pragma unroll
    for (int e = 0; e < 8; ++e) { x[e] *= kkw[e]; ss += x[e] * x[e]; }
    ss = grp8_sum(ss);
    const float rn = rsqrtf(ss + 1e-12f);
#pragma unroll
    for (int e = 0; e < 8; ++e) x[e] *= rn;
    kkp = PACK8(x);
  }
  {
    const int sp = lat ? t : s, sl = lat ? T : CTX;
    float gb[8], zb[8], g0[8], u0[8], gm[8], um[8], gp[8], up[8];
    u32x4 raw;
    raw = *(const u32x4*)(pr + C_GB + lane * 8); UNPACK8(raw, gb);
    raw = *(const u32x4*)(pr + C_ZB + lane * 8); UNPACK8(raw, zb);
    raw = *(const u32x4*)(pr + C_GC + lane * 8); UNPACK8(raw, g0);
    raw = *(const u32x4*)(pr + C_U + lane * 8); UNPACK8(raw, u0);
    if (sp > 0) {
      raw = *(const u32x4*)(pr - NP + C_GC + lane * 8); UNPACK8(raw, gm);
      raw = *(const u32x4*)(pr - NP + C_U + lane * 8); UNPACK8(raw, um);
    } else {
#pragma unroll
      for (int e = 0; e < 8; ++e) { gm[e] = 0.f; um[e] = 0.f; }
    }
    if (sp < sl - 1) {
      raw = *(const u32x4*)(pr + NP + C_GC + lane * 8); UNPACK8(raw, gp);
      raw = *(const u32x4*)(pr + NP + C_U + lane * 8); UNPACK8(raw, up);
    } else {
#pragma unroll
      for (int e = 0; e < 8; ++e) { gp[e] = 0.f; up[e] = 0.f; }
    }
    const float* cw = p.conv_w + l * 3 * 512 + lane * 8;
    const float* cb = p.conv_b + l * 512 + lane * 8;
    float y[8];
#pragma unroll
    for (int e = 0; e < 8; ++e) {
      float cv = cw[e] * gm[e] * um[e] + cw[512 + e] * g0[e] * u0[e] + cw[1024 + e] * gp[e] * up[e] + cb[e];
      y[e] = gb[e] * cv * siluf_(zb[e]);
    }
    *(u32x4*)(pr + C_YB + lane * 8) = PACK8(y);
  }
  *(u32x4*)(pr + C_KK + lane * 8) = kkp;
}
__device__ void phase_prep(const Params& p, int l, char* lds) {
  const int tid = opaque_tid(), lane = tid & 63, wid = tid >> 6;
  const int nspan = M / 136;
  for (int sp = blockIdx.x; sp < nspan; sp += gridDim.x) {
    const int row0 = sp * 136, b = row0 / S, s0 = row0 % S;
    for (int i = tid; i < 136 * 64; i += NTHR) {
      const int tok = i >> 6, ch = i & 63;
      *(u32x4*)(lds + tok * 1040 + ch * 16) = *(const u32x4*)(WS_PROJ(p) + (size_t)(row0 + tok) * NP + C_VD + ch * 8);
    }
    __syncthreads();
    for (int i = tid; i < 512 * 17; i += NTHR) {
      const int dv = i / 17, cch = i - dv * 17, head = dv >> 7, dvl = dv & 127;
      unsigned short e[8];
#pragma unroll
      for (int q = 0; q < 8; ++q) e[q] = *(const unsigned short*)(lds + (cch * 8 + q) * 1040 + dv * 2);
      u32x4 o = {(unsigned)e[0] | ((unsigned)e[1] << 16), (unsigned)e[2] | ((unsigned)e[3] << 16), (unsigned)e[4] | ((unsigned)e[5] << 16),
                 (unsigned)e[6] | ((unsigned)e[7] << 16)};
      *(u32x4*)(WS_VT(p) + ((size_t)(b * 4 + head) * 128 + dvl) * S + s0 + cch * 8) = o;
    }
    for (int i = 0; i < 17; ++i) prep_token(p, l, row0 + wid * 17 + i, lane);
    __syncthreads();
  }
}

constexpr int SC_CH = 32;
constexpr int SC_TS = 68, SC_VS = 36;
constexpr int SC_ARR = SC_CH * SC_TS * 4;
constexpr int SC_R = 0, SC_KK = SC_ARR, SC_W = 2 * SC_ARR, SC_KD = 3 * SC_ARR, SC_AK = 4 * SC_ARR, SC_V = 5 * SC_ARR, SC_BUF = 5 * SC_ARR + SC_CH * SC_VS * 4;
constexpr int SC_Y = 2 * SC_BUF;
constexpr int SC_WF = SC_Y + 8192;
__device__ __forceinline__ int scan_row(int b, int dir, int j) {
  const int s = dir == 0 ? j : (j < CTX ? (CTX - 1 - j) : (S + CTX - 1 - j));
  return b * S + s;
}
__device__ void phase_scan(const Params& p, int l, char* lds) {
  const int tid = opaque_tid(), lane = tid & 63, wid = tid >> 6, fr = lane & 15, fq = lane >> 4;
  for (int u = blockIdx.x; u < 256; u += gridDim.x) {
    const int pr_ = (u & 7) * 8 + (u >> 5), hd_ = (u >> 3) & 3;
    const int half = hd_ & 1, dir = hd_ >> 1, h = pr_ & 7, b = pr_ >> 3;
    const int c_lw = dir ? C_LWB : C_LWF, c_la = dir ? C_LAB : C_LAF, c_ys = dir ? C_YSB : C_YSF;
    if (wid == 4) {
      const float* du = p.decay_up + (size_t)(l * 2 + dir) * 64 * 512 + h * 64;
      const float* iu = p.iclr_up + (size_t)(l * 2 + dir) * 64 * 512 + h * 64;
#pragma unroll 1
      for (int f8 = 0; f8 < 8; ++f8) {
        const int nt = f8 >> 1, ks = f8 & 1;
        float fd[8], fi[8];
#pragma unroll
        for (int e = 0; e < 8; ++e) {
          const int k = ks * 32 + fq * 8 + e;
          fd[e] = du[(size_t)k * 512 + nt * 16 + fr];
          fi[e] = iu[(size_t)k * 512 + nt * 16 + fr];
        }
        *(u32x4*)(lds + SC_WF + (f8 * 64 + lane) * 16) = PACK8(fd);
        *(u32x4*)(lds + SC_WF + 8192 + (f8 * 64 + lane) * 16) = PACK8(fi);
      }
    }
    __syncthreads();
    const int pq = wid - 4, pth = pq & 1, pn0 = (pq >> 1) * 2, pti = pth * 16 + fr;
    bf16x8 P_tl[2], P_ta[2];
    u32x2 P_r[2], P_k[2], P_kk[2];
    u32x2 P_v;
    auto pload = [&](int c) {
      const bf16_t* pr = WS_PROJ(p) + (size_t)scan_row(b, dir, c * SC_CH + pti) * NP;
#pragma unroll
      for (int ks = 0; ks < 2; ++ks) {
        P_tl[ks] = *(const bf16x8*)(pr + c_lw + ks * 32 + fq * 8);
        P_ta[ks] = *(const bf16x8*)(pr + c_la + ks * 32 + fq * 8);
      }
#pragma unroll
      for (int n2 = 0; n2 < 2; ++n2) {
        const int gch = h * 64 + (pn0 + n2) * 16 + 4 * fq;
        P_r[n2] = *(const u32x2*)(pr + C_R + gch);
        P_k[n2] = *(const u32x2*)(pr + C_K + gch);
        P_kk[n2] = *(const u32x2*)(pr + C_KK + gch);
      }
      P_v = *(const u32x2*)(pr + C_V + h * 64 + half * 32 + (pq >> 1) * 16 + fq * 4);
    };
    f32x4 Cw0[2], Ca0[2], Cka[2];
    if (wid >= 4) {
#pragma unroll
      for (int n2 = 0; n2 < 2; ++n2) {
        const int gch = h * 64 + (pn0 + n2) * 16 + 4 * fq;
        Cw0[n2] = *(const f32x4*)(p.decay_w0 + (l * 2 + dir) * 512 + gch);
        Ca0[n2] = *(const f32x4*)(p.iclr_a0 + (l * 2 + dir) * 512 + gch);
        Cka[n2] = *(const f32x4*)(p.k_a + l * 512 + gch);
      }
    }
    auto pcompute = [&](int c) {
      char* buf = lds + (c & 1) * SC_BUF;
#pragma unroll
      for (int n2 = 0; n2 < 2; ++n2) {
        const int nt = pn0 + n2;
        f32x4 aw = {0.f, 0.f, 0.f, 0.f}, aa = {0.f, 0.f, 0.f, 0.f};
#pragma unroll
        for (int ks = 0; ks < 2; ++ks) {
          const bf16x8 wd = *(const bf16x8*)(lds + SC_WF + ((nt * 2 + ks) * 64 + lane) * 16);
          const bf16x8 wi = *(const bf16x8*)(lds + SC_WF + 8192 + ((nt * 2 + ks) * 64 + lane) * 16);
          aw = __builtin_amdgcn_mfma_f32_16x16x32_bf16(wd, P_tl[ks], aw, 0, 0, 0);
          aa = __builtin_amdgcn_mfma_f32_16x16x32_bf16(wi, P_ta[ks], aa, 0, 0, 0);
        }
        const int ch = nt * 16 + 4 * fq, gch = h * 64 + ch;
        const f32x4 w0 = Cw0[n2], a0 = Ca0[n2], ka = Cka[n2];
        const u32x2 r2 = P_r[n2], k2 = P_k[n2], kk2 = P_kk[n2];
        const f32x4 rv = {bf_lo(r2.x), bf_hi(r2.x), bf_lo(r2.y), bf_hi(r2.y)};
        const f32x4 kv = {bf_lo(k2.x), bf_hi(k2.x), bf_lo(k2.y), bf_hi(k2.y)};
        const f32x4 kkv = {bf_lo(kk2.x), bf_hi(kk2.x), bf_lo(kk2.y), bf_hi(kk2.y)};
        f32x4 wv, kd, ak;
#pragma unroll
        for (int j = 0; j < 4; ++j) {
          const float sg = sigmoidf_(aw[j] + w0[j]);
          wv[j] = __expf(-0.6065306597f * sg);
          const float a = sigmoidf_(aa[j] + a0[j]);
          kd[j] = kv[j] * (1.f + (a - 1.f) * ka[j]);
          ak[j] = a * kkv[j];
        }
        const int o = (pti * SC_TS + ch) * 4;
        *(f32x4*)(buf + SC_R + o) = rv;
        *(f32x4*)(buf + SC_KK + o) = kkv;
        *(f32x4*)(buf + SC_W + o) = wv;
        *(f32x4*)(buf + SC_KD + o) = kd;
        *(f32x4*)(buf + SC_AK + o) = ak;
      }
      *(f32x4*)(buf + SC_V + (pti * SC_VS + (pq >> 1) * 16 + fq * 4) * 4) = (f32x4){bf_lo(P_v.x), bf_hi(P_v.x), bf_lo(P_v.y), bf_hi(P_v.y)};
    };
    auto flush_y = [&](int c) {
      const int pt = tid - 256, tok = pt >> 3, r4 = (pt & 7) * 4;
      const f32x4 yv = *(const f32x4*)((const float*)(lds + SC_Y) + (c & 1) * 1024 + tok * 32 + r4);
      const int row = scan_row(b, dir, c * SC_CH + tok);
      const u32x2 o = {pack_bf16(yv.x, yv.y), pack_bf16(yv.z, yv.w)};
      *(u32x2*)(WS_PROJ(p) + (size_t)row * NP + c_ys + h * 64 + half * 32 + r4) = o;
    };
    const int nchunk = S / SC_CH;
    if (wid >= 4) { pload(0); pcompute(0); pload(1); }
    __syncthreads();
    f32x2 S2[4];
#pragma unroll
    for (int i = 0; i < 4; ++i) S2[i] = (f32x2){0.f, 0.f};
    const int rl = lane >> 3, cg8 = lane & 7;
    for (int c = 0; c < nchunk; ++c) {
      if (wid < 4) {
        const char* buf = lds + (c & 1) * SC_BUF;
        float* yb = (float*)(lds + SC_Y) + (c & 1) * 1024;
#define SC_LOAD(P, i_)                                                                                         \
  {                                                                                                            \
    const int o_ = ((i_) * SC_TS + cg8 * 8) * 4;                                                                  \
    P##ka = *(const f32x4*)(buf + SC_KK + o_); P##kb = *(const f32x4*)(buf + SC_KK + o_ + 16);                 \
    P##wa = *(const f32x4*)(buf + SC_W + o_);  P##wb = *(const f32x4*)(buf + SC_W + o_ + 16);                  \
    P##da = *(const f32x4*)(buf + SC_KD + o_); P##db = *(const f32x4*)(buf + SC_KD + o_ + 16);                 \
    P##aa = *(const f32x4*)(buf + SC_AK + o_); P##ab = *(const f32x4*)(buf + SC_AK + o_ + 16);                 \
    P##ra = *(const f32x4*)(buf + SC_R + o_);  P##rb = *(const f32x4*)(buf + SC_R + o_ + 16);                  \
    P##vv = *(const float*)(buf + SC_V + ((i_) * SC_VS + wid * 8 + rl) * 4);                                      \
  }
#define SC_STEP(P, i_)                                                                                         \
  {                                                                                                            \
    f32x2 d2 = S2[0] * (f32x2){P##ka.x, P##ka.y};                                                              \
    d2 = __builtin_elementwise_fma(S2[1], (f32x2){P##ka.z, P##ka.w}, d2);                                      \
    d2 = __builtin_elementwise_fma(S2[2], (f32x2){P##kb.x, P##kb.y}, d2);                                      \
    d2 = __builtin_elementwise_fma(S2[3], (f32x2){P##kb.z, P##kb.w}, d2);                                      \
      \
    float ra_ = d2.x + d2.y, rb_ = ypend;                                                                     \
    ra_ += dppf<0xB1>(ra_); rb_ += dppf<0xB1>(rb_);                                                            \
    ra_ += dppf<0x4E>(ra_); rb_ += dppf<0x4E>(rb_);                                                            \
    ra_ += dppf<0x141>(ra_); rb_ += dppf<0x141>(rb_);                                                          \
    yb[((i_) > 0 ? (i_) - 1 : 0) * 32 + wid * 8 + rl] = rb_;     \
    const float skk = ra_;                                                                                     \
    const f32x2 v2 = {P##vv, P##vv}, nk2 = {-skk, -skk};                                                       \
    f32x2 t0 = v2 * (f32x2){P##da.x, P##da.y}, t1 = v2 * (f32x2){P##da.z, P##da.w};                            \
    f32x2 t2 = v2 * (f32x2){P##db.x, P##db.y}, t3 = v2 * (f32x2){P##db.z, P##db.w};                            \
    t0 = __builtin_elementwise_fma(nk2, (f32x2){P##aa.x, P##aa.y}, t0);                                        \
    t1 = __builtin_elementwise_fma(nk2, (f32x2){P##aa.z, P##aa.w}, t1);                                        \
    t2 = __builtin_elementwise_fma(nk2, (f32x2){P##ab.x, P##ab.y}, t2);                                        \
    t3 = __builtin_elementwise_fma(nk2, (f32x2){P##ab.z, P##ab.w}, t3);                                        \
    S2[0] = __builtin_elementwise_fma(S2[0], (f32x2){P##wa.x, P##wa.y}, t0);                                   \
    S2[1] = __builtin_elementwise_fma(S2[1], (f32x2){P##wa.z, P##wa.w}, t1);                                   \
    S2[2] = __builtin_elementwise_fma(S2[2], (f32x2){P##wb.x, P##wb.y}, t2);                                   \
    S2[3] = __builtin_elementwise_fma(S2[3], (f32x2){P##wb.z, P##wb.w}, t3);                                   \
    f32x2 y2 = S2[0] * (f32x2){P##ra.x, P##ra.y};                                                              \
    y2 = __builtin_elementwise_fma(S2[1], (f32x2){P##ra.z, P##ra.w}, y2);                                      \
    y2 = __builtin_elementwise_fma(S2[2], (f32x2){P##rb.x, P##rb.y}, y2);                                      \
    y2 = __builtin_elementwise_fma(S2[3], (f32x2){P##rb.z, P##rb.w}, y2);                                      \
    ypend = y2.x + y2.y;                                         \
  }
        f32x4 Aka, Akb, Awa, Awb, Ada, Adb, Aaa, Aab, Ara, Arb, Bka, Bkb, Bwa, Bwb, Bda, Bdb, Baa, Bab, Bra, Brb;
        float Avv, Bvv, ypend = 0.f;
        SC_LOAD(A, 0);
#pragma unroll 4
        for (int i = 0; i < SC_CH; i += 2) {
          SC_LOAD(B, i + 1);
          SC_STEP(A, i);
          if (i + 2 < SC_CH) SC_LOAD(A, i + 2);
          SC_STEP(B, i + 1);
        }
        yb[(SC_CH - 1) * 32 + wid * 8 + rl] = allreduce8(ypend);
      } else {
        if (c + 1 < nchunk) pcompute(c + 1);
        if (c + 2 < nchunk) pload(c + 2);
        if (c > 0) flush_y(c - 1);
      }
      __syncthreads();
    }
    if (wid >= 4) flush_y(nchunk - 1);
    __syncthreads();
  }
}

constexpr int A_STAGE = 35840, A_VOFF = 17408, A_VSTR = 136;
__device__ void attn_unit(const Params& p, int l, int b, int head, int q0, int nkt, float lam, float lam_init, float bound2, char* lds) {
  int lane = __builtin_amdgcn_mbcnt_hi(~0u, __builtin_amdgcn_mbcnt_lo(~0u, 0u));
  asm volatile("" : "+v"(lane));
  const int wid = __builtin_amdgcn_readfirstlane(threadIdx.x >> 6), tid = wid * 64 + lane, fr = lane & 15, fq = lane >> 4;
  const int qrow = b * S + q0 + wid * 16 + fr;
  bf16x8 qf[2][2];
#pragma unroll
  for (int c = 0; c < 2; ++c)
#pragma unroll
    for (int ks = 0; ks < 2; ++ks) qf[c][ks] = *(const bf16x8*)(WS_PROJ(p) + (size_t)qrow * NP + C_QD + head * 128 + c * 64 + ks * 32 + fq * 8);
  f32x4 O[2][8];
  float ls[2] = {0.f, 0.f};
#pragma unroll
  for (int c = 0; c < 2; ++c)
#pragma unroll
    for (int dt = 0; dt < 8; ++dt) O[c][dt] = (f32x4){0.f, 0.f, 0.f, 0.f};
  const bf16_t* kg = WS_PROJ(p) + (size_t)(b * S + (tid >> 4)) * NP + C_KD + head * 128 + (tid & 15) * 8;
  const bf16_t* vg = WS_VT(p) + ((size_t)(b * 4 + head) * 128 + (tid >> 3)) * S + (tid & 7) * 8;
  const int ksto = (tid >> 4) * 272 + (tid & 15) * 16, vsto = A_VOFF + (tid >> 3) * A_VSTR + (tid & 7) * 16;
  u32x4 rk[2], rv[2];
#pragma unroll
  for (int i = 0; i < 2; ++i) {
    rk[i] = *(const u32x4*)(kg + (size_t)(32 * i) * NP);
    rv[i] = *(const u32x4*)(vg + (size_t)(64 * i) * S);
  }
#pragma unroll
  for (int i = 0; i < 2; ++i) {
    *(u32x4*)(lds + ksto + i * 32 * 272) = rk[i];
    *(u32x2*)(lds + vsto + i * 64 * A_VSTR) = (u32x2){rv[i].x, rv[i].y};
    *(u32x2*)(lds + vsto + i * 64 * A_VSTR + 8) = (u32x2){rv[i].z, rv[i].w};
  }
  __syncthreads();
  for (int kt = 0; kt < nkt; ++kt) {
    const char* base = lds + (kt & 1) * A_STAGE;
    const bool more = kt + 1 < nkt;
    if (more) {
#pragma unroll
      for (int i = 0; i < 2; ++i) {
        rk[i] = *(const u32x4*)(kg + (size_t)((kt + 1) * 64 + 32 * i) * NP);
        rv[i] = *(const u32x4*)(vg + (size_t)(64 * i) * S + (kt + 1) * 64);
      }
    }
#pragma unroll
    for (int g = 0; g < 2; ++g) {
      bf16x8 pf[2];
#pragma unroll
      for (int c = 0; c < 2; ++c) {
        f32x4 sa[2];
        sa[0] = (f32x4){-bound2, -bound2, -bound2, -bound2};
        sa[1] = sa[0];
#pragma unroll
        for (int ks = 0; ks < 2; ++ks)
#pragma unroll
          for (int k2 = 0; k2 < 2; ++k2) {
            const bf16x8 kf = *(const bf16x8*)(base + ((g * 2 + k2) * 16 + fr) * 272 + (c * 64 + ks * 32 + fq * 8) * 2);
            sa[k2] = __builtin_amdgcn_mfma_f32_16x16x32_bf16(kf, qf[c][ks], sa[k2], 0, 0, 0);
          }
        float acc_l = 0.f;
#pragma unroll
        for (int k2 = 0; k2 < 2; ++k2)
#pragma unroll
          for (int j = 0; j < 4; ++j) {
            const float pe = __builtin_amdgcn_exp2f(sa[k2][j]);
            sa[k2][j] = pe;
            acc_l += pe;
          }
        ls[c] += acc_l;
        u32x4 pk = {pack_bf16_b(sa[0][0], sa[0][1]), pack_bf16_b(sa[0][2], sa[0][3]), pack_bf16_b(sa[1][0], sa[1][1]), pack_bf16_b(sa[1][2], sa[1][3])};
        pf[c] = __builtin_bit_cast(bf16x8, pk);
      }
#pragma unroll
      for (int dt = 0; dt < 8; ++dt) {
        const u32x2 v0 = *(const u32x2*)(base + A_VOFF + (dt * 16 + fr) * A_VSTR + (g * 32 + 4 * fq) * 2);
        const u32x2 v1 = *(const u32x2*)(base + A_VOFF + (dt * 16 + fr) * A_VSTR + (g * 32 + 16 + 4 * fq) * 2);
        const u32x4 vv = {v0.x, v0.y, v1.x, v1.y};
        const bf16x8 vf = __builtin_bit_cast(bf16x8, vv);
        O[0][dt] = __builtin_amdgcn_mfma_f32_16x16x32_bf16(vf, pf[0], O[0][dt], 0, 0, 0);
        O[1][dt] = __builtin_amdgcn_mfma_f32_16x16x32_bf16(vf, pf[1], O[1][dt], 0, 0, 0);
      }
    }
    if (more) {
      char* nb = lds + ((kt + 1) & 1) * A_STAGE;
#pragma unroll
      for (int i = 0; i < 2; ++i) {
        *(u32x4*)(nb + ksto + i * 32 * 272) = rk[i];
        *(u32x2*)(nb + vsto + i * 64 * A_VSTR) = (u32x2){rv[i].x, rv[i].y};
        *(u32x2*)(nb + vsto + i * 64 * A_VSTR + 8) = (u32x2){rv[i].z, rv[i].w};
      }
    }
    __syncthreads();
  }
  float l0 = ls[0], l1 = ls[1];
  l0 += shflx(l0, 16, lane); l0 += shflx(l0, 32, lane);
  l1 += shflx(l1, 16, lane); l1 += shflx(l1, 32, lane);
  const float i0 = 1.f / l0, i1 = lam / l1;
  float ss = 0.f;
#pragma unroll
  for (int dt = 0; dt < 8; ++dt) {
    f32x4 o = O[0][dt] * i0 - O[1][dt] * i1;
    O[0][dt] = o;
    ss += o.x * o.x + o.y * o.y + o.z * o.z + o.w * o.w;
  }
  ss += shflx(ss, 16, lane); ss += shflx(ss, 32, lane);
  const float rn = rsqrtf(ss * (1.f / 128.f) + 1e-6f) * (1.f - lam_init);
  bf16_t* pr = WS_PROJ(p) + (size_t)qrow * NP + head * 128 + 4 * fq;
  const float* sg = p.subln_g + l * 128 + 4 * fq;
#pragma unroll
  for (int dt = 0; dt < 8; ++dt) {
    const int dv = dt * 16;
    const u32x2 z2 = *(const u32x2*)(pr + C_ZC + dv);
    const f32x4 g4 = *(const f32x4*)(sg + dv);
    const f32x4 o = O[0][dt];
    const float y0 = o.x * rn * g4.x * siluf_(bf_lo(z2.x)), y1 = o.y * rn * g4.y * siluf_(bf_hi(z2.x));
    const float y2 = o.z * rn * g4.z * siluf_(bf_lo(z2.y)), y3 = o.w * rn * g4.w * siluf_(bf_hi(z2.y));
    u32x2 ov = {pack_bf16(y0, y1), pack_bf16(y2, y3)};
    *(u32x2*)(pr + C_YC + dv) = ov;
  }
}
__device__ __forceinline__ void rwkv_out_token(const Params& p, int l, int row, int lane) {
  bf16_t* pr = WS_PROJ(p) + (size_t)row * NP;
  float yf[8], yb[8], r[8], k[8], v[8], z[8];
  u32x4 raw;
  raw = *(const u32x4*)(pr + C_YSF + lane * 8); UNPACK8(raw, yf);
  raw = *(const u32x4*)(pr + C_YSB + lane * 8); UNPACK8(raw, yb);
  raw = *(const u32x4*)(pr + C_R + lane * 8); UNPACK8(raw, r);
  raw = *(const u32x4*)(pr + C_K + lane * 8); UNPACK8(raw, k);
  raw = *(const u32x4*)(pr + C_V + lane * 8); UNPACK8(raw, v);
  raw = *(const u32x4*)(pr + C_ZA + lane * 8); UNPACK8(raw, z);
  const float* rk = p.r_k + l * 512 + lane * 8;
  const float* gg = p.gn_g + l * 512 + lane * 8;
  const float* gb = p.gn_b + l * 512 + lane * 8;
  float sm = 0.f, bs = 0.f;
#pragma unroll
  for (int e = 0; e < 8; ++e) { yf[e] += yb[e]; sm += yf[e]; bs += r[e] * k[e] * rk[e]; }
  sm = grp8_sum(sm); bs = grp8_sum(bs);
  const float mu = sm * (1.f / 64.f);
  float vs = 0.f;
#pragma unroll
  for (int e = 0; e < 8; ++e) { yf[e] -= mu; vs += yf[e] * yf[e]; }
  vs = grp8_sum(vs);
  const float rs = rsqrtf(vs * (1.f / 64.f) + 64e-5f);
  float o[8];
#pragma unroll
  for (int e = 0; e < 8; ++e) o[e] = (yf[e] * rs * gg[e] + gb[e] + bs * v[e]) * siluf_(z[e]);
  *(u32x4*)(pr + C_YA + lane * 8) = PACK8(o);
}
__device__ void phase_attn(const Params& p, int l, char* lds) {
  const int tid0 = opaque_tid();
  const int lane = tid0 & 63;
  const float lam_init = __int_as_float(__builtin_amdgcn_readfirstlane(__float_as_int(0.8f - 0.6f * __expf(-0.3f * (float)l))));
  const float* lq = p.lambda_qk + l * 256;
  float a1 = lq[lane] * lq[64 + lane], a2 = lq[128 + lane] * lq[192 + lane];
  a1 = wave_sum(a1); a2 = wave_sum(a2);
  const float lam = __int_as_float(__builtin_amdgcn_readfirstlane(__float_as_int(__expf(a1) - __expf(a2) + lam_init)));
  const float* qg = p.qk_norm_g + l * 128;
  float mq = fabsf(qg[lane]), mk = fabsf(qg[64 + lane]);
  mq = wave_max(mq); mk = wave_max(mk);
  const float bound2 = __int_as_float(__builtin_amdgcn_readfirstlane(__float_as_int(8.f * mq * mk * 1.44269504f * 1.02f + 0.1f)));
  const int nunit = (l < NL - 1) ? 1088 : 1024;
  for (int u = blockIdx.x; u < nunit; u += gridDim.x) {
    int b, head, q0, nkt;
    if (u < 1024) {
      const int xcd = u & 7, j = u >> 3, pair = xcd + 8 * (j >> 5), qb = j & 31;
      head = pair & 3; b = pair >> 2; q0 = CTX + qb * 128; nkt = S / 64;
    } else {
      const int v = u - 1024; head = (v >> 1) & 3; b = v >> 3; q0 = (v & 1) * 128; nkt = CTX / 64;
    }
    attn_unit(p, l, b, head, q0, nkt, lam, lam_init, bound2, lds);
  }
  const int tid1 = opaque_tid();
  const int gw = blockIdx.x * 8 + (tid1 >> 6), nw = gridDim.x * 8;
  for (int row = gw; row < M; row += nw) rwkv_out_token(p, l, row, tid1 & 63);
}

__device__ void phase_merge1(const Params& p, int l, char* lds) {
  const int tid = opaque_tid(), lane = tid & 63, wid = tid >> 6, wm = wid >> 1, wn = wid & 1, fr = lane & 15, fq = lane >> 4;
  const int xcd = blockIdx.x & 7, bi = blockIdx.x >> 3, nbx = (gridDim.x + 7 - xcd) >> 3;
  for (int idx = bi; idx < 17 * 8; idx += nbx) {
    const int mt = 17 * xcd + (idx >> 3), nt = idx & 7;
    if (l == NL - 1 && (mt % 17) == 0) continue;
    u32x2 macc[4][4];
#pragma unroll
    for (int mi = 0; mi < 4; ++mi)
#pragma unroll
      for (int ni = 0; ni < 4; ++ni) macc[mi][ni] = (u32x2){0u, 0u};
#pragma unroll 1
    for (int i = 0; i < 3; ++i) {
      const int ycol = i == 0 ? C_YA : (i == 1 ? C_YB : C_YC);
      f32x4 acc[4][4];
#pragma unroll
      for (int mi = 0; mi < 4; ++mi)
#pragma unroll
        for (int ni = 0; ni < 4; ++ni) acc[mi][ni] = (f32x4){0.f, 0.f, 0.f, 0.f};
      gemm_256x128_dma(WS_PROJ(p) + (size_t)mt * 256 * NP + ycol, NP, WS_WB(p) + (size_t)(l & 1) * WSET + ((size_t)i * D + nt * 128) * 512, 512, 512, acc, lds, tid);
      u32x2 br[4][4];
#pragma unroll
      for (int mi = 0; mi < 4; ++mi)
#pragma unroll
        for (int ni = 0; ni < 4; ++ni) {
          const f32x4 av = mfma_guard(acc[mi][ni]);
          br[mi][ni] = (u32x2){pack_bf16(av.x, av.y), pack_bf16(av.z, av.w)};
          acc[mi][ni] = (f32x4){0.f, 0.f, 0.f, 0.f};
        }
      gemm_256x128_dma(WS_H(p) + (size_t)mt * 256 * D, D, WS_WG(p) + (size_t)(l & 1) * WSET + ((size_t)i * D + nt * 128) * D, D, D, acc, lds, tid);
#pragma unroll
      for (int mi = 0; mi < 4; ++mi)
#pragma unroll
        for (int ni = 0; ni < 4; ++ni) {
          const f32x4 a = acc[mi][ni];
          const u32x2 bb = br[mi][ni], mm = macc[mi][ni];
          const float m0 = bf_lo(mm.x) + sigmoidf_(a.x) * bf_lo(bb.x), m1 = bf_hi(mm.x) + sigmoidf_(a.y) * bf_hi(bb.x);
          const float m2 = bf_lo(mm.y) + sigmoidf_(a.z) * bf_lo(bb.y), m3 = bf_hi(mm.y) + sigmoidf_(a.w) * bf_hi(bb.y);
          macc[mi][ni] = (u32x2){pack_bf16(m0, m1), pack_bf16(m2, m3)};
        }
    }
#pragma unroll
    for (int mi = 0; mi < 4; ++mi) {
      const int row = mt * 256 + wm * 64 + mi * 16 + fr;
#pragma unroll
      for (int ni = 0; ni < 4; ++ni) {
        const int col = nt * 128 + wn * 64 + ni * 16 + 4 * fq;
        *(u32x2*)(WS_PROJ(p) + (size_t)row * NP + ((nt < 4) ? C_M0 : (C_M1 - 512)) + col) = macc[mi][ni];
      }
    }
  }
}

__device__ void phase_merge2(const Params& p, int l, char* lds) {
  const int tid = opaque_tid(), lane = tid & 63, wid = tid >> 6, wm = wid >> 1, wn = wid & 1, fr = lane & 15, fq = lane >> 4;
  const int xcd = blockIdx.x & 7, bi = blockIdx.x >> 3, nbx = (gridDim.x + 7 - xcd) >> 3;
  for (int idx = bi; idx < 17 * 8; idx += nbx) {
    const int mt = 17 * xcd + (idx >> 3), nt = idx & 7;
    const bool isctx = (mt % 17) == 0;
    if (l == NL - 1 && isctx) continue;
    f32x4 acc[4][4];
#pragma unroll
    for (int mi = 0; mi < 4; ++mi)
#pragma unroll
      for (int ni = 0; ni < 4; ++ni) acc[mi][ni] = (f32x4){0.f, 0.f, 0.f, 0.f};
    gemm_256x128_dma(WS_PROJ(p) + (size_t)mt * 256 * NP + C_M0, NP, WS_WO(p) + (size_t)(l & 1) * WSET + (size_t)nt * 128 * D, D, D, acc, lds, tid, 8,
                     (C_M1 - C_M0 - 512) * 2);
    const int b = mt / 17;
    const float* gate = WS_MOD(p) + ((size_t)l * 9 + (isctx ? 8 : b)) * 3072 + 2048;
#pragma unroll
    for (int mi = 0; mi < 4; ++mi) {
      const int row = mt * 256 + wm * 64 + mi * 16 + fr, s = row - b * S;
      const float* xs = xrow_src(p, l, b, s);
      float* xd = isctx ? (WS_CTXS(p) + ((size_t)b * CTX + s) * D) : (p.out + ((size_t)b * T + (s - CTX)) * D);
#pragma unroll
      for (int ni = 0; ni < 4; ++ni) {
        const int col = nt * 128 + wn * 64 + ni * 16 + 4 * fq;
        const f32x4 g = *(const f32x4*)(gate + col);
        const f32x4 xv = *(const f32x4*)(xs + col);
        *(f32x4*)(xd + col) = xv + g * acc[mi][ni];
      }
    }
  }
}

#ifndef MULTI_LAUNCH
#define MULTI_LAUNCH 0
#endif
#ifndef DUMP_STAGE
#define DUMP_STAGE 0
#define NL_RUN 4
#define PROBE_MEMSET 1
#endif
#if !MULTI_LAUNCH && !DUMP_STAGE
__device__ __forceinline__ void l2_refresh(const Params& p, unsigned seq) {
  const float* base = (seq & 1u) ? p.x : p.w_in;
  const f32x4* src = (const f32x4*)(base + (size_t)blockIdx.x * 131072) + threadIdx.x;
  f32x4 a = {0.f, 0.f, 0.f, 0.f};
#pragma unroll 4
  for (int i = 0; i < 64; ++i) a += src[i * NTHR];
  asm volatile("" ::"v"(a.x), "v"(a.y), "v"(a.z), "v"(a.w));
}

__device__ __forceinline__ void grid_barrier(unsigned* bar, unsigned target) {
  asm volatile("s_waitcnt vmcnt(0) lgkmcnt(0)" ::: "memory");
  __syncthreads();
  if (threadIdx.x == 0) {
    __builtin_amdgcn_fence(__ATOMIC_RELEASE, "");
    asm volatile("s_waitcnt vmcnt(0)" ::: "memory");
    __hip_atomic_fetch_add(bar, 1u, __ATOMIC_RELAXED, __HIP_MEMORY_SCOPE_AGENT);
    while ((int)(__hip_atomic_load(bar, __ATOMIC_RELAXED, __HIP_MEMORY_SCOPE_AGENT) - target) < 0) __builtin_amdgcn_s_sleep(2);
    __builtin_amdgcn_fence(__ATOMIC_ACQUIRE, "");
    asm volatile("s_waitcnt vmcnt(0)" ::: "memory");
  }
  __syncthreads();
}

__device__ void phase_dump(const Params& p, int what) {
  const size_t n = (size_t)NB * T * D;
  for (size_t i = blockIdx.x * (size_t)NTHR + threadIdx.x; i < n; i += (size_t)gridDim.x * NTHR) {
    float v = 0.f;
    if (what == 1) { const int rr = (int)(i / D) % S; v = bf_lo(WS_H(p)[i]); (void)rr; }
    else if (what == 7) v = bf_lo(WS_WG(p)[i % ((size_t)3072 * D)]) + bf_lo(WS_WB(p)[i % ((size_t)1536 * D)]) + bf_lo(WS_WO(p)[i % ((size_t)D * D)]);
    else if (what == 6) { const unsigned* q = (const unsigned*)(WS_PROJ(p) + i * 6);
      for (int j = 0; j < 3; ++j) { unsigned w = __hip_atomic_load(q + j, __ATOMIC_RELAXED, __HIP_MEMORY_SCOPE_AGENT); v += bf_lo(w) + bf_hi(w); } }
    else { for (int j = 0; j < 6; ++j) v += bf_lo(WS_PROJ(p)[i * 6 + j]); if (what == 3) v += bf_lo(WS_VT(p)[i % ((size_t)NB * 4 * 128 * S)]); }
    p.out[i] = v;
  }
}
#ifndef PROBE_TWICE
#define PROBE_TWICE 0
#endif
#ifndef MK_DUMP
#define MK_DUMP 0
#define MK_DUMP_L 0
#endif
__global__ void __launch_bounds__(NTHR) fwd_megakernel(Params p, int l0, int l1) {
  __shared__ __attribute__((aligned(16))) char lds[LDS_BYTES];
  cg::grid_group grid = cg::this_grid();
  unsigned nbar = __builtin_amdgcn_readfirstlane(__hip_atomic_load(WS_BAR(p), __ATOMIC_RELAXED, __HIP_MEMORY_SCOPE_AGENT));
  grid.sync();
  const unsigned nblk = gridDim.x;
#define NL_MK 2
  unsigned nflush = 0;
#define GSYNC() do { nbar += nblk; grid_barrier(WS_BAR(p), nbar); } while (0)
#define GSYNC_REFRESH() do { nbar += nblk; grid_barrier(WS_BAR(p), nbar); l2_refresh(p, nflush++); nbar += nblk; grid_barrier(WS_BAR(p), nbar); } while (0)
  if (l0 == 0) { phase_mod(p, lds); GSYNC(); }
  for (int l = l0; l < l1; ++l) {
    if (MK_DUMP == 8 && l == MK_DUMP_L) return;
    phase_norm(p, l);
    if (l == l0) phase_cvt(p, l, lds, blockIdx.x, gridDim.x);
    GSYNC();
    if (MK_DUMP == 1 && l == MK_DUMP_L) { phase_dump(p, 1); return; }
    if (MK_DUMP == 7 && l == MK_DUMP_L) { phase_dump(p, 7); return; }
    phase_inproj(p, l, lds);
#if PROBE_TWICE == 1
    GSYNC(); phase_inproj(p, l, lds);
#endif
    GSYNC();
    if (MK_DUMP == 2 && l == MK_DUMP_L) { phase_dump(p, 2); return; }
    phase_prep(p, l, lds);
    GSYNC();
    if (MK_DUMP == 3 && l == MK_DUMP_L) { phase_dump(p, 3); return; }
    phase_scan(p, l, lds);
#if PROBE_TWICE == 2
    GSYNC(); phase_scan(p, l, lds);
#endif
    GSYNC_REFRESH();
    if (MK_DUMP == 4 && l == MK_DUMP_L) { phase_dump(p, 4); return; }
    phase_attn(p, l, lds);
    GSYNC();
    if (MK_DUMP == 5 && l == MK_DUMP_L) { phase_dump(p, 5); return; }
    phase_merge1(p, l, lds);
#if PROBE_TWICE == 3
    GSYNC(); phase_merge1(p, l, lds);
#endif
    GSYNC();
    if (MK_DUMP == 6 && l == MK_DUMP_L) { phase_dump(p, 6); return; }
    phase_merge2(p, l, lds);
    if (l + 1 < l1) {
      if (gridDim.x == 256) { const int bi = blockIdx.x >> 3; if (bi >= 8) phase_cvt(p, l + 1, lds, (bi - 8) * 8 + (blockIdx.x & 7), 192); }
      else phase_cvt(p, l + 1, lds, blockIdx.x, gridDim.x);
    }
    if (l + 1 < l1) GSYNC_REFRESH();
  }
}
#endif
#if MULTI_LAUNCH || DUMP_STAGE
__global__ void __launch_bounds__(NTHR) phase_kernel(Params p, int phase, int l) {
  __shared__ __attribute__((aligned(16))) char lds[LDS_BYTES];
  switch (phase) {
    case 0: phase_mod(p, lds); break;
    case 1: phase_norm(p, l); phase_cvt(p, l, lds, blockIdx.x, gridDim.x); break;
    case 2: phase_inproj(p, l, lds); break;
    case 3: phase_prep(p, l, lds); break;
    case 4: phase_scan(p, l, lds); break;
    case 5: phase_attn(p, l, lds); break;
    case 6: phase_merge1(p, l, lds); break;
    default: phase_merge2(p, l, lds); break;
  }
}

__global__ void dump_kernel(Params p, int stage, int n) {
  for (size_t i = blockIdx.x * (size_t)blockDim.x + threadIdx.x; i < (size_t)n; i += (size_t)gridDim.x * blockDim.x) {
    float v = 0.f;
    if (stage == 1) v = WS_MOD(p)[i % (NL * 9 * 3072)];
    else if (stage == 2) v = bf_lo(WS_H(p)[i]);
    else if (stage == 3) v = bf_lo(WS_WIN(p)[i % ((size_t)NP * D)]) + bf_lo(WS_WG(p)[i % ((size_t)3072 * D)]) + bf_lo(WS_WB(p)[i % ((size_t)1536 * D)]) + bf_lo(WS_WO(p)[i % ((size_t)D * D)]);
    else if (stage == 4 || stage == 5) { for (int j = 0; j < 6; ++j) v += bf_lo(WS_PROJ(p)[i * 6 + j]); if (stage == 5) v += bf_lo(WS_VT(p)[i % ((size_t)NB * 4 * 128 * S)]); }
    p.out[i] = v;
  }
}
#endif

extern "C" void kernel_launch(void* const* d_in, const int* in_sizes, int n_in, void* d_out, int out_size, void* d_ws, size_t ws_size,
                              hipStream_t stream) {
  static int grid_blocks = 0;
#if !MULTI_LAUNCH && !DUMP_STAGE
  if (!grid_blocks) {
    int dev = 0, cus = 0, per_cu = 0;
    hipGetDevice(&dev);
    hipDeviceGetAttribute(&cus, hipDeviceAttributeMultiprocessorCount, dev);
    hipOccupancyMaxActiveBlocksPerMultiprocessor(&per_cu, fwd_megakernel, NTHR, 0);
    if (per_cu < 1) per_cu = 1;
    grid_blocks = cus * per_cu;
  }
#endif
  Params p{};
  const float** f = (const float**)&p;
  for (int i = 0; i < 24; ++i) f[i] = (const float*)d_in[i];
  p.out = (float*)d_out;
  p.ws = (char*)d_ws;
  const size_t off = WS_TOTAL;
  if (off > ws_size) { fprintf(stderr, "workspace too small: need %zu have %zu\n", off, ws_size); return; }
  hipMemsetAsync(WS_BAR(p), 0, 256, stream);
#if DUMP_STAGE
  {
    const int maxph = DUMP_STAGE == 1 ? 0 : (DUMP_STAGE <= 3 ? 1 : (DUMP_STAGE == 4 ? 2 : 3));
    for (int ph = 0; ph <= maxph; ++ph) phase_kernel<<<dim3(256), dim3(NTHR), 0, stream>>>(p, ph, 0);
    dump_kernel<<<dim3(1024), dim3(256), 0, stream>>>(p, DUMP_STAGE, out_size);
    return;
  }
#endif
#if MULTI_LAUNCH
  phase_kernel<<<dim3(256), dim3(NTHR), 0, stream>>>(p, 0, 0);
  for (int l = 0; l < NL_RUN; ++l)
    for (int ph = 1; ph <= 7; ++ph) {
#ifdef SKIP_SCAN
      if (ph == 4) continue;
#endif
#ifdef SKIP_ATTN
      if (ph == 5) continue;
#endif
      phase_kernel<<<dim3(256), dim3(NTHR), 0, stream>>>(p, ph, l);
    }
  return;
#endif
#if !MULTI_LAUNCH && !DUMP_STAGE
#ifndef LAYERS_PER_LAUNCH
#define LAYERS_PER_LAUNCH 4
#endif
  for (int l0 = 0; l0 < (MK_DUMP ? MK_DUMP_L + 1 : NL); l0 += LAYERS_PER_LAUNCH) {
    int a0 = l0, a1 = l0 + LAYERS_PER_LAUNCH;
    void* args[] = {&p, &a0, &a1};
    hipError_t e = hipLaunchCooperativeKernel((void*)fwd_megakernel, dim3(grid_blocks), dim3(NTHR), args, 0, stream);
    if (e != hipSuccess) fprintf(stderr, "cooperative launch failed: %s (grid %d)\n", hipGetErrorString(e), grid_blocks);
  }
#endif
}
```

```cpp
#include <hip/hip_runtime.h>
#include <hip/hip_cooperative_groups.h>
#include <cstdio>
#include <cstdint>
namespace cg = cooperative_groups;

typedef unsigned short bf16_t;
typedef short bf16x8 __attribute__((ext_vector_type(8)));
typedef float f32x4 __attribute__((ext_vector_type(4)));
typedef float f32x2 __attribute__((ext_vector_type(2)));
typedef unsigned u32x4 __attribute__((ext_vector_type(4)));
typedef unsigned u32x2 __attribute__((ext_vector_type(2)));

constexpr int D = 1024, NB = 8, T = 4096, NL = 4, CTX = 256, S = T + CTX, M = NB * S, NP = 6400, NIN = 9472;
constexpr int C_R = 0, C_K = 512, C_V = 1024, C_LWF = 1536, C_LWB = 1600, C_LAF = 1664, C_LAB = 1728, C_ZA = 1792,
              C_GB = 2304, C_GC = 2816, C_U = 3328, C_ZB = 3840, C_QD = 4352, C_KD = 4864, C_VD = 5376, C_ZC = 5888;
constexpr int C_YA = C_R, C_YB = C_GB, C_YC = C_QD, C_M0 = C_ZB, C_M1 = C_VD, C_YSF = C_GC, C_YSB = C_U, C_KK = C_ZB;
constexpr int NTHR = 512;
constexpr size_t WSET = (size_t)NP * D + (size_t)3072 * D + (size_t)3 * D * 512 + (size_t)D * D;
constexpr int LDS_BYTES = 147456;

struct Params {
  const float *x, *c, *ctx, *c_ctx, *w_mod, *b_mod, *norm_g, *w_in, *decay_w0, *decay_up, *iclr_a0, *iclr_up, *k_k, *k_a, *r_k,
      *gn_g, *gn_b, *conv_w, *conv_b, *qk_norm_g, *lambda_qk, *subln_g, *w_branch, *w_out;
  float* out;
  char* ws;
};
constexpr size_t al256(size_t x) { return (x + 255) & ~(size_t)255; }
constexpr size_t WSET_C = (size_t)NP * D + (size_t)3072 * D + (size_t)3 * D * 512 + (size_t)D * D;
constexpr size_t OFF_PROJ = 0;
constexpr size_t OFF_H = OFF_PROJ + al256((size_t)M * NP * 2);
constexpr size_t OFF_VT = OFF_H + al256((size_t)M * D * 2);
constexpr size_t OFF_W = OFF_VT + al256((size_t)NB * 4 * 128 * S * 2);
constexpr size_t OFF_CTXS = OFF_W + al256(2 * WSET_C * 2);
constexpr size_t OFF_MOD = OFF_CTXS + al256((size_t)NB * CTX * D * 4);
constexpr size_t OFF_BAR = OFF_MOD + al256((size_t)NL * 9 * 3072 * 4);
constexpr size_t WS_TOTAL = OFF_BAR + 256;
#define WS_PROJ(p) ((bf16_t*)((p).ws + OFF_PROJ))
#define WS_H(p) ((bf16_t*)((p).ws + OFF_H))
#define WS_VT(p) ((bf16_t*)((p).ws + OFF_VT))
#define WS_WIN(p) ((bf16_t*)((p).ws + OFF_W))
#define WS_WG(p) (WS_WIN(p) + (size_t)NP * D)
#define WS_WB(p) (WS_WG(p) + (size_t)3072 * D)
#define WS_WO(p) (WS_WB(p) + (size_t)3 * D * 512)
#define WS_CTXS(p) ((float*)((p).ws + OFF_CTXS))
#define WS_MOD(p) ((float*)((p).ws + OFF_MOD))
#define WS_BAR(p) ((unsigned*)((p).ws + OFF_BAR))

__device__ __forceinline__ int opaque_tid() { int t = threadIdx.x; asm volatile("" : "+v"(t)); return t; }
__device__ __forceinline__ float bf_lo(unsigned u) { return __uint_as_float(u << 16); }
__device__ __forceinline__ float bf_hi(unsigned u) { return __uint_as_float(u & 0xffff0000u); }
__device__ __forceinline__ unsigned pack_bf16(float lo, float hi) {
  unsigned r;
  asm("s_nop 0\n\tv_cvt_pk_bf16_f32 %0, %1, %2" : "=v"(r) : "v"(lo), "v"(hi));
  return r;
}
__device__ __forceinline__ float vmul_(float a, float b) { float d; asm("v_mul_f32 %0, %1, %2" : "=v"(d) : "v"(a), "v"(b)); return d; }
__device__ __forceinline__ float vfma_(float a, float b, float c) { float d; asm("v_fma_f32 %0, %1, %2, %3" : "=v"(d) : "v"(a), "v"(b), "v"(c)); return d; }
__device__ __forceinline__ float vfnma_(float a, float b, float c) { float d; asm("v_fma_f32 %0, -%1, %2, %3" : "=v"(d) : "v"(a), "v"(b), "v"(c)); return d; }
typedef __bf16 bf16v2_t __attribute__((ext_vector_type(2)));
__device__ __forceinline__ unsigned pack_bf16_b(float lo, float hi) {
  const f32x2 v = {lo, hi};
  return __builtin_bit_cast(unsigned, __builtin_convertvector(v, bf16v2_t));
}
__device__ __forceinline__ f32x4 mfma_guard(f32x4 v) { return v + (f32x4){0.f, 0.f, 0.f, 0.f}; }
__device__ __forceinline__ float sigmoidf_(float x) { return __builtin_amdgcn_rcpf(1.f + __expf(-x)); }
__device__ __forceinline__ float siluf_(float x) { return x * sigmoidf_(x); }
__device__ __forceinline__ float tanhf_(float x) { return 1.f - 2.f * __builtin_amdgcn_rcpf(__expf(2.f * x) + 1.f); }
template <int CTRL> __device__ __forceinline__ float dppf(float x) {
  return __int_as_float(__builtin_amdgcn_update_dpp(0, __float_as_int(x), CTRL, 0xF, 0xF, true));
}
__device__ __forceinline__ float allreduce8(float x) {
  x += dppf<0xB1>(x);
  x += dppf<0x4E>(x);
  x += dppf<0x141>(x);
  return x;
}
__device__ __forceinline__ float grp8_sum(float v) { return allreduce8(v); }
__device__ __forceinline__ float wave_sum(float v) {
  v = allreduce8(v);
  v += dppf<0x140>(v);
  return __int_as_float(__builtin_amdgcn_readlane(__float_as_int(v), 0)) + __int_as_float(__builtin_amdgcn_readlane(__float_as_int(v), 16)) +
         __int_as_float(__builtin_amdgcn_readlane(__float_as_int(v), 32)) + __int_as_float(__builtin_amdgcn_readlane(__float_as_int(v), 48));
}
__device__ __forceinline__ float wave_max(float v) {
  v = fmaxf(v, dppf<0xB1>(v));
  v = fmaxf(v, dppf<0x4E>(v));
  v = fmaxf(v, dppf<0x141>(v));
  v = fmaxf(v, dppf<0x140>(v));
  return fmaxf(fmaxf(__int_as_float(__builtin_amdgcn_readlane(__float_as_int(v), 0)), __int_as_float(__builtin_amdgcn_readlane(__float_as_int(v), 16))),
               fmaxf(__int_as_float(__builtin_amdgcn_readlane(__float_as_int(v), 32)), __int_as_float(__builtin_amdgcn_readlane(__float_as_int(v), 48))));
}
__device__ __forceinline__ float shflx(float v, int mask, int lane) {
  return __int_as_float(__builtin_amdgcn_ds_bpermute((lane ^ mask) << 2, __float_as_int(v)));
}
#define UNPACK8(raw, f)                                                                                  \
  {                                                                                                      \
    f[0] = bf_lo(raw.x); f[1] = bf_hi(raw.x); f[2] = bf_lo(raw.y); f[3] = bf_hi(raw.y);                  \
    f[4] = bf_lo(raw.z); f[5] = bf_hi(raw.z); f[6] = bf_lo(raw.w); f[7] = bf_hi(raw.w);                  \
  }
#define PACK8(f) ((u32x4){pack_bf16(f[0], f[1]), pack_bf16(f[2], f[3]), pack_bf16(f[4], f[5]), pack_bf16(f[6], f[7])})

constexpr int G_STAGE = 55296, G_BOFF = 36864;
__device__ __forceinline__ void gemm_256x128(const bf16_t* A, int lda, const bf16_t* Bt, int ldb, int K,
                                             f32x4 (&acc)[4][4], char* lds, const int tid) {
  const int lane = tid & 63, wid = tid >> 6, wm = wid >> 1, wn = wid & 1, fr = lane & 15, fq = lane >> 4;
  const int srow = tid >> 3, sch = tid & 7;
  const bf16_t* ag = A + (size_t)srow * lda + sch * 8;
  const bf16_t* bg = Bt + (size_t)srow * ldb + sch * 8;
  u32x4 ra[4], rb[2];
  const int nk = K >> 6;
#pragma unroll
  for (int i = 0; i < 4; ++i) ra[i] = *(const u32x4*)(ag + (size_t)(64 * i) * lda);
#pragma unroll
  for (int i = 0; i < 2; ++i) rb[i] = *(const u32x4*)(bg + (size_t)(64 * i) * ldb);
#pragma unroll
  for (int i = 0; i < 4; ++i) *(u32x4*)(lds + (srow + 64 * i) * 144 + sch * 16) = ra[i];
#pragma unroll
  for (int i = 0; i < 2; ++i) *(u32x4*)(lds + G_BOFF + (srow + 64 * i) * 144 + sch * 16) = rb[i];
  __syncthreads();
  for (int kt = 0; kt < nk; ++kt) {
    const bool more = (kt + 1 < nk);
    if (more) {
#pragma unroll
      for (int i = 0; i < 4; ++i) ra[i] = *(const u32x4*)(ag + (size_t)(64 * i) * lda + (kt + 1) * 64);
#pragma unroll
      for (int i = 0; i < 2; ++i) rb[i] = *(const u32x4*)(bg + (size_t)(64 * i) * ldb + (kt + 1) * 64);
    }
    const char* base = lds + (kt & 1) * G_STAGE;
#pragma unroll
    for (int ks = 0; ks < 2; ++ks) {
      bf16x8 af[4], bfr[4];
#pragma unroll
      for (int mi = 0; mi < 4; ++mi) af[mi] = *(const bf16x8*)(base + (wm * 64 + mi * 16 + fr) * 144 + ks * 64 + fq * 16);
#pragma unroll
      for (int ni = 0; ni < 4; ++ni) bfr[ni] = *(const bf16x8*)(base + G_BOFF + (wn * 64 + ni * 16 + fr) * 144 + ks * 64 + fq * 16);
#pragma unroll
      for (int mi = 0; mi < 4; ++mi)
#pragma unroll
        for (int ni = 0; ni < 4; ++ni) acc[mi][ni] = __builtin_amdgcn_mfma_f32_16x16x32_bf16(bfr[ni], af[mi], acc[mi][ni], 0, 0, 0);
    }
    if (more) {
      char* nb = lds + ((kt + 1) & 1) * G_STAGE;
#pragma unroll
      for (int i = 0; i < 4; ++i) *(u32x4*)(nb + (srow + 64 * i) * 144 + sch * 16) = ra[i];
#pragma unroll
      for (int i = 0; i < 2; ++i) *(u32x4*)(nb + G_BOFF + (srow + 64 * i) * 144 + sch * 16) = rb[i];
    }
    __syncthreads();
  }
}

__device__ __forceinline__ void gemm_256x128_deep(const bf16_t* A, int lda, const bf16_t* Bt, int ldb, int K, f32x4 (&acc)[4][4], char* lds,
                                                  const int tid) {
  const int lane = tid & 63, wid = tid >> 6, wm = wid >> 1, wn = wid & 1, fr = lane & 15, fq = lane >> 4;
  const int srow = tid >> 3, sch = tid & 7;
  const bf16_t* ag = A + (size_t)srow * lda + sch * 8;
  const bf16_t* bg = Bt + (size_t)srow * ldb + sch * 8;
  u32x4 ra0[4], rb0[2], ra1[4], rb1[2];
  const int nk = K >> 6;
#define GLOAD(RA, RB, kt_)                                                                                  \
  {                                                                                                         \
    _Pragma("unroll") for (int i = 0; i < 4; ++i) RA[i] = *(const u32x4*)(ag + (size_t)(64 * i) * lda + (kt_) * 64); \
    _Pragma("unroll") for (int i = 0; i < 2; ++i) RB[i] = *(const u32x4*)(bg + (size_t)(64 * i) * ldb + (kt_) * 64); \
  }
#define LSTORE(RA, RB, st_)                                                                                 \
  {                                                                                                         \
    char* nb_ = lds + (st_) * G_STAGE;                                                                      \
    _Pragma("unroll") for (int i = 0; i < 4; ++i) *(u32x4*)(nb_ + (srow + 64 * i) * 144 + sch * 16) = RA[i]; \
    _Pragma("unroll") for (int i = 0; i < 2; ++i) *(u32x4*)(nb_ + G_BOFF + (srow + 64 * i) * 144 + sch * 16) = RB[i]; \
  }
#define GCOMPUTE(st_)                                                                                       \
  {                                                                                                         \
    const char* base_ = lds + (st_) * G_STAGE;                                                              \
    _Pragma("unroll") for (int ks = 0; ks < 2; ++ks) {                                                      \
      bf16x8 af[4], bfr[4];                                                                                 \
      _Pragma("unroll") for (int mi = 0; mi < 4; ++mi) af[mi] = *(const bf16x8*)(base_ + (wm * 64 + mi * 16 + fr) * 144 + ks * 64 + fq * 16); \
      _Pragma("unroll") for (int ni = 0; ni < 4; ++ni) bfr[ni] = *(const bf16x8*)(base_ + G_BOFF + (wn * 64 + ni * 16 + fr) * 144 + ks * 64 + fq * 16); \
      _Pragma("unroll") for (int mi = 0; mi < 4; ++mi)                                                      \
        _Pragma("unroll") for (int ni = 0; ni < 4; ++ni) acc[mi][ni] = __builtin_amdgcn_mfma_f32_16x16x32_bf16(bfr[ni], af[mi], acc[mi][ni], 0, 0, 0); \
    }                                                                                                       \
  }
  GLOAD(ra0, rb0, 0);
  LSTORE(ra0, rb0, 0);
  GLOAD(ra0, rb0, 1);
  __syncthreads();
#pragma unroll 1
  for (int kt = 0; kt < nk; kt += 2) {
    if (kt + 2 < nk) GLOAD(ra1, rb1, kt + 2);
    GCOMPUTE(0);
    LSTORE(ra0, rb0, 1);
    __syncthreads();
    if (kt + 3 < nk) GLOAD(ra0, rb0, kt + 3);
    GCOMPUTE(1);
    if (kt + 2 < nk) LSTORE(ra1, rb1, 0);
    __syncthreads();
  }
#undef GLOAD
#undef LSTORE
#undef GCOMPUTE
}

#define LAS __attribute__((address_space(3)))
constexpr int D_STAGE = 49152;
__device__ __forceinline__ int dma_lds_byte(int r, int c) {
  const int st = (r >> 4) * 2 + (c >> 5), rr = r & 15, cc = c & 31, ob = rr * 64 + cc * 2;
  return st * 1024 + (ob ^ (((ob >> 9) & 1) << 5));
}
__device__ __forceinline__ void dma_stage_rc(int b, int& R, int& C) {
  const int st = b / 1024, sb = b % 1024, swz = sb ^ (((sb >> 9) & 1) << 5);
  R = (st >> 1) * 16 + swz / 64;
  C = (st & 1) * 32 + (swz % 64) / 2;
}
__device__ __forceinline__ void gemm_256x128_dma(const bf16_t* A, int lda, const bf16_t* Bt, int ldb, int K, f32x4 (&acc)[4][4], char* lds,
                                                 const int tid, const int ksplit = 1 << 30, const int asplit_bytes = 0) {
  const int lane = tid & 63, wid = __builtin_amdgcn_readfirstlane(tid >> 6), wm = wid >> 1, wn = wid & 1, fr = lane & 15, fq = lane >> 4;
  unsigned voffA[2], voffB[2];
#pragma unroll
  for (int i = 0; i < 2; ++i) {
    int R, C;
    dma_stage_rc(tid * 16 + i * 8192, R, C);
    voffA[i] = (unsigned)(R * lda + C) * 2u;
    voffB[i] = (unsigned)(R * ldb + C) * 2u;
  }
  const char* Ab = (const char*)A;
  const char* Bb = (const char*)Bt;
  const size_t ahalf = (size_t)128 * lda * 2;
  LAS char* l3 = (LAS char*)lds;
  const unsigned ldsw = (unsigned)wid * 1024u;
  const int aoff = (wm >> 1) * 16384 + dma_lds_byte((wm & 1) * 64 + fr, fq * 8);
  const int boff = 32768 + dma_lds_byte(wn * 64 + fr, fq * 8);
  const int nk = K >> 6;
#define DMA_STAGE(kt_, sbase_)                                                                                               \
  {                                                                                                                          \
    const char* ga_ = Ab + (size_t)(kt_) * 128 + ((kt_) >= ksplit ? asplit_bytes : 0);                                                                              \
    const char* gb_ = Bb + (size_t)(kt_) * 128;                                                                              \
    _Pragma("unroll") for (int i_ = 0; i_ < 2; ++i_) {                                                                       \
      __builtin_amdgcn_global_load_lds((const unsigned*)(ga_ + voffA[i_]), (LAS unsigned*)(l3 + (sbase_) + ldsw + i_ * 8192), 16, 0, 0);          \
      __builtin_amdgcn_global_load_lds((const unsigned*)(ga_ + ahalf + voffA[i_]), (LAS unsigned*)(l3 + (sbase_) + 16384 + ldsw + i_ * 8192), 16, 0, 0); \
      __builtin_amdgcn_global_load_lds((const unsigned*)(gb_ + voffB[i_]), (LAS unsigned*)(l3 + (sbase_) + 32768 + ldsw + i_ * 8192), 16, 0, 0);  \
    }                                                                                                                        \
  }
  asm volatile("s_waitcnt vmcnt(0)" ::: "memory");
  DMA_STAGE(0, 0);
  DMA_STAGE(1, D_STAGE);
  asm volatile("s_waitcnt vmcnt(6)" ::: "memory");
  __builtin_amdgcn_s_barrier();
  int sc = 0, sn = 2 * D_STAGE;
#pragma unroll 1
  for (int kt = 0; kt < nk; ++kt) {
    const bool pre = kt + 2 < nk;
    if (pre) DMA_STAGE(kt + 2, sn);
    {
      const LAS char* base = l3 + sc;
#pragma unroll
      for (int ks = 0; ks < 2; ++ks) {
        bf16x8 af[4], bfr[4];
#pragma unroll
        for (int mi = 0; mi < 4; ++mi) af[mi] = *(const LAS bf16x8*)(base + aoff + mi * 2048 + ks * 1024);
#pragma unroll
        for (int ni = 0; ni < 4; ++ni) bfr[ni] = *(const LAS bf16x8*)(base + boff + ni * 2048 + ks * 1024);
        __builtin_amdgcn_sched_barrier(0);
#pragma unroll
        for (int mi = 0; mi < 4; ++mi)
#pragma unroll
          for (int ni = 0; ni < 4; ++ni) acc[mi][ni] = __builtin_amdgcn_mfma_f32_16x16x32_bf16(bfr[ni], af[mi], acc[mi][ni], 0, 0, 0);
      }
    }
    if (pre) asm volatile("s_waitcnt vmcnt(6)" ::: "memory");
    else asm volatile("s_waitcnt vmcnt(0)" ::: "memory");
    __builtin_amdgcn_s_barrier();
    sc = (sc == 2 * D_STAGE) ? 0 : sc + D_STAGE;
    sn = (sn == 2 * D_STAGE) ? 0 : sn + D_STAGE;
  }
#undef DMA_STAGE
}

__device__ __forceinline__ void gemm_256x256_dma(const bf16_t* A, int lda, const bf16_t* Bt, int ldb, int K, f32x4 (&acc)[8][4], char* lds,
                                                 const int tid) {
  const int lane = tid & 63, wid = __builtin_amdgcn_readfirstlane(tid >> 6), wm = wid >> 2, wn = wid & 3, fr = lane & 15, fq = lane >> 4;
  unsigned voffA[2], voffB[2];
#pragma unroll
  for (int i = 0; i < 2; ++i) {
    int R, C;
    dma_stage_rc(tid * 16 + i * 8192, R, C);
    voffA[i] = (unsigned)(R * lda + C) * 2u;
    voffB[i] = (unsigned)(R * ldb + C) * 2u;
  }
  const char* Ab = (const char*)A;
  const char* Bb = (const char*)Bt;
  const size_t ahalf = (size_t)128 * lda * 2, bhalf = (size_t)128 * ldb * 2;
  LAS char* l3 = (LAS char*)lds;
  const unsigned ldsw = (unsigned)wid * 1024u;
  const int aoff = wm * 16384 + dma_lds_byte(fr, fq * 8);
  const int boff = 32768 + (wn >> 1) * 16384 + dma_lds_byte((wn & 1) * 64 + fr, fq * 8);
  const int nk = K >> 6;
#define DMA_STAGE4(kt_, sbase_)                                                                                              \
  {                                                                                                                          \
    const char* ga_ = Ab + (size_t)(kt_) * 128;                                                                              \
    const char* gb_ = Bb + (size_t)(kt_) * 128;                                                                              \
    _Pragma("unroll") for (int i_ = 0; i_ < 2; ++i_) {                                                                       \
      __builtin_amdgcn_global_load_lds((const unsigned*)(ga_ + voffA[i_]), (LAS unsigned*)(l3 + (sbase_) + ldsw + i_ * 8192), 16, 0, 0);          \
      __builtin_amdgcn_global_load_lds((const unsigned*)(ga_ + ahalf + voffA[i_]), (LAS unsigned*)(l3 + (sbase_) + 16384 + ldsw + i_ * 8192), 16, 0, 0); \
      __builtin_amdgcn_global_load_lds((const unsigned*)(gb_ + voffB[i_]), (LAS unsigned*)(l3 + (sbase_) + 32768 + ldsw + i_ * 8192), 16, 0, 0);  \
      __builtin_amdgcn_global_load_lds((const unsigned*)(gb_ + bhalf + voffB[i_]), (LAS unsigned*)(l3 + (sbase_) + 49152 + ldsw + i_ * 8192), 16, 0, 0); \
    }                                                                                                                        \
  }
  asm volatile("s_waitcnt vmcnt(0)" ::: "memory");
  DMA_STAGE4(0, 0);
  asm volatile("s_waitcnt vmcnt(0)" ::: "memory");
  __builtin_amdgcn_s_barrier();
#pragma unroll 1
  for (int kt = 0; kt < nk; ++kt) {
    const int sc = (kt & 1) * 65536;
    if (kt + 1 < nk) DMA_STAGE4(kt + 1, 65536 - sc);
    {
      const LAS char* base = l3 + sc;
#pragma unroll
      for (int ks = 0; ks < 2; ++ks) {
        bf16x8 af[8], bfr[4];
#pragma unroll
        for (int ni = 0; ni < 4; ++ni) bfr[ni] = *(const LAS bf16x8*)(base + boff + ni * 2048 + ks * 1024);
#pragma unroll
        for (int mi = 0; mi < 8; ++mi) af[mi] = *(const LAS bf16x8*)(base + aoff + mi * 2048 + ks * 1024);
        __builtin_amdgcn_sched_barrier(0);
#pragma unroll
        for (int mi = 0; mi < 8; ++mi)
#pragma unroll
          for (int ni = 0; ni < 4; ++ni) acc[mi][ni] = __builtin_amdgcn_mfma_f32_16x16x32_bf16(bfr[ni], af[mi], acc[mi][ni], 0, 0, 0);
      }
    }
    asm volatile("s_waitcnt vmcnt(0)" ::: "memory");
    __builtin_amdgcn_s_barrier();
  }
#undef DMA_STAGE4
}

__device__ void phase_mod(const Params& p, char* lds) {
  const int tid = opaque_tid();
  float* sc = (float*)lds;
  for (int i = tid; i < 9 * 1024; i += NTHR) {
    int s = i >> 10, k = i & 1023;
    float v = s < 8 ? p.c[s * 1024 + k] : p.c_ctx[k];
    sc[i] = siluf_(v);
  }
  __syncthreads();
  float* red = sc + 9 * 1024;
  for (int u = blockIdx.x; u < NL * 48; u += gridDim.x) {
    const int l = u / 48, n0 = (u % 48) * 64, col = tid & 63, kq = tid >> 6;
    const float* w = p.w_mod + (size_t)l * 1024 * 3072 + (size_t)(kq * 128) * 3072 + n0 + col;
    float a[9];
#pragma unroll
    for (int s = 0; s < 9; ++s) a[s] = 0.f;
#pragma unroll 4
    for (int k = 0; k < 128; ++k) {
      float wv = w[(size_t)k * 3072];
#pragma unroll
      for (int s = 0; s < 9; ++s) a[s] += sc[s * 1024 + kq * 128 + k] * wv;
    }
#pragma unroll
    for (int s = 0; s < 9; ++s) red[(kq * 64 + col) * 9 + s] = a[s];
    __syncthreads();
    for (int o = tid; o < 576; o += NTHR) {
      int cc = o / 9, s = o % 9;
      float t = 0.f;
#pragma unroll
      for (int q = 0; q < 8; ++q) t += red[(q * 64 + cc) * 9 + s];
      WS_MOD(p)[((size_t)l * 9 + s) * 3072 + n0 + cc] = t + p.b_mod[l * 3072 + n0 + cc];
    }
    __syncthreads();
  }
}

__device__ __forceinline__ void cvt_tile(const float* src, int ldsrc, bf16_t* dst, int K, int k0, int n0, float* tl, const int tid) {
#pragma unroll
  for (int i = 0; i < 2; ++i) {
    int kk = (tid >> 4) + 32 * i, nn = (tid & 15) * 4;
    f32x4 v = *(const f32x4*)(src + (size_t)(k0 + kk) * ldsrc + n0 + nn);
    tl[kk * 65 + nn + 0] = v.x; tl[kk * 65 + nn + 1] = v.y; tl[kk * 65 + nn + 2] = v.z; tl[kk * 65 + nn + 3] = v.w;
  }
  __syncthreads();
  {
    int n = tid >> 3, k8 = (tid & 7) * 8;
    float f[8];
#pragma unroll
    for (int e = 0; e < 8; ++e) f[e] = tl[(k8 + e) * 65 + n];
    *(u32x4*)(dst + (size_t)(n0 + n) * K + k0 + k8) = PACK8(f);
  }
  __syncthreads();
}
__device__ void phase_cvt(const Params& p, int l, char* lds, int rank, int stride) {
  const int tid = opaque_tid();
  float* tl = (float*)lds;
  const size_t wso = (size_t)(l & 1) * WSET;
  const float* win = p.w_in + (size_t)l * D * NIN;
  const float* wbr = p.w_branch + (size_t)l * 3 * 512 * D;
  const float* wo = p.w_out + (size_t)l * D * D;
  for (int u = rank; u < 3008; u += stride) {
    if (u < 2368) {
      int kt = u / 148, nt = u % 148;
      if (nt < 100) cvt_tile(win, NIN, WS_WIN(p) + wso, D, kt * 64, nt * 64, tl, tid);
      else cvt_tile(win + 6400, NIN, WS_WG(p) + wso, D, kt * 64, (nt - 100) * 64, tl, tid);
    } else if (u < 2368 + 384) {
      int v = u - 2368, i = v / 128, r = v % 128, kt = r / 16, nt = r % 16;
      cvt_tile(wbr + (size_t)i * 512 * D, D, WS_WB(p) + wso + (size_t)i * D * 512, 512, kt * 64, nt * 64, tl, tid);
    } else {
      int v = u - 2752, kt = v / 16, nt = v % 16;
      cvt_tile(wo, D, WS_WO(p) + wso, D, kt * 64, nt * 64, tl, tid);
    }
  }
}

__device__ __forceinline__ const float* xrow_src(const Params& p, int l, int b, int s) {
  return (s < CTX) ? ((l == 0 ? p.ctx : WS_CTXS(p)) + ((size_t)b * CTX + s) * D) : ((l == 0 ? p.x : p.out) + ((size_t)b * T + (s - CTX)) * D);
}
__device__ void phase_norm(const Params& p, int l) {
  const int tid = opaque_tid();
  const int gw = blockIdx.x * 8 + (tid >> 6), nw = gridDim.x * 8, lane = tid & 63;
  const float* ng = p.norm_g + l * D;
  for (int row = gw; row < M; row += nw) {
    const int b = row / S, s = row % S;
    const float* xr = xrow_src(p, l, b, s);
#ifndef PROBE_NORM
#define PROBE_NORM 0
#endif
    const float* md = WS_MOD(p) + ((size_t)(PROBE_NORM == 1 ? 0 : l) * 9 + (s < CTX ? 8 : b)) * 3072;
    f32x4 v[4];
    float ss = 0.f;
#pragma unroll
    for (int i = 0; i < 4; ++i) {
      v[i] = *(const f32x4*)(xr + i * 256 + lane * 4);
      ss += v[i].x * v[i].x + v[i].y * v[i].y + v[i].z * v[i].z + v[i].w * v[i].w;
    }
    ss = wave_sum(ss);
    const float rstd = rsqrtf(ss * (1.f / 1024.f) + 1e-6f);
#pragma unroll
    for (int i = 0; i < 4; ++i) {
      const int col = i * 256 + lane * 4;
      f32x4 g = *(const f32x4*)(ng + col), sh = *(const f32x4*)(md + col), sc = *(const f32x4*)(md + 1024 + col);
      f32x4 y = v[i] * rstd * g * (1.f + sc) + sh;
      u32x2 o = {pack_bf16(y.x, y.y), pack_bf16(y.z, y.w)};
      *(u32x2*)(WS_H(p) + (size_t)row * D + col) = o;
    }
  }
}

__device__ void phase_inproj(const Params& p, int l, char* lds) {
  const int tid = opaque_tid(), lane = tid & 63, wid = tid >> 6, wm = wid >> 2, wn = wid & 3, fr = lane & 15, fq = lane >> 4;
  const int xcd = blockIdx.x & 7, bi = blockIdx.x >> 3, nbx = (gridDim.x + 7 - xcd) >> 3;
  for (int idx = bi; idx < 17 * 25; idx += nbx) {
    int ml, nl, mg, ng;
    if (idx < 400) {
      mg = idx / 100;
      const int rem = idx - mg * 100;
      ng = rem >> 5;
      const int rem2 = rem & 31;
      if (ng < 3) { ml = rem2 & 3; nl = rem2 >> 2; } else { ml = rem2; nl = 0; }
    } else { mg = 4; ng = 0; ml = 0; nl = idx - 400; }
    const int mt = 17 * xcd + mg * 4 + ml, nt = ng * 8 + nl;
    f32x4 acc[8][4];
#pragma unroll
    for (int mi = 0; mi < 8; ++mi)
#pragma unroll
      for (int ni = 0; ni < 4; ++ni) acc[mi][ni] = (f32x4){0.f, 0.f, 0.f, 0.f};
    gemm_256x256_dma(WS_H(p) + (size_t)mt * 256 * D, D, WS_WIN(p) + (size_t)(l & 1) * WSET + (size_t)nt * 256 * D, D, D, acc, lds, tid);
    const bool dotanh = (nt == 6) && (wn < 2);
    char* wl = lds + wid * 18432;
#pragma unroll
    for (int mi = 0; mi < 8; ++mi)
#pragma unroll
      for (int ni = 0; ni < 4; ++ni) {
        f32x4 v = mfma_guard(acc[mi][ni]);
        if (dotanh) { v.x = tanhf_(v.x); v.y = tanhf_(v.y); v.z = tanhf_(v.z); v.w = tanhf_(v.w); }
        const u32x2 o = {pack_bf16(v.x, v.y), pack_bf16(v.z, v.w)};
        *(u32x2*)(wl + (mi * 16 + fr) * 144 + (ni * 16 + 4 * fq) * 2) = o;
      }
    {
      const int rr = lane >> 3, cc = lane & 7;
      bf16_t* gbase = WS_PROJ(p) + (size_t)(mt * 256 + wm * 128) * NP + nt * 256 + wn * 64 + cc * 8;
#pragma unroll
      for (int j = 0; j < 16; ++j) {
        const int r = j * 8 + rr;
        const u32x4 o = *(const u32x4*)(wl + r * 144 + cc * 16);
        *(u32x4*)(gbase + (size_t)r * NP) = o;
      }
    }
    __syncthreads();
  }
}

__device__ __forceinline__ void prep_token(const Params& p, int l, int row, int lane) {
  const int s = row % S;
  const bool lat = s >= CTX;
  const int t = s - CTX;
  bf16_t* pr = WS_PROJ(p) + (size_t)row * NP;
  const int gi = lane & 7, d0 = gi * 8;
  float cs[8], sn[8];
  if (lat) {
    const float pos = (gi >> 2) ? (float)(t & 63) : (float)(t >> 6);
#pragma unroll
    for (int e = 0; e < 8; ++e) {
      float fr_ = __builtin_amdgcn_exp2f(-(float)((gi & 1) * 8 + e) * 0.830482024f);
      float rev = pos * fr_ * 0.15915494309f;
      rev = rev - floorf(rev);
      cs[e] = __builtin_amdgcn_cosf(rev);
      sn[e] = __builtin_amdgcn_sinf(rev);
    }
  } else {
#pragma unroll
    for (int e = 0; e < 8; ++e) { cs[e] = 1.f; sn[e] = 0.f; }
  }
  const float sgn = ((gi >> 1) & 1) ? 1.f : -1.f;
#pragma unroll
  for (int which = 0; which < 2; ++which) {
    bf16_t* ptr = pr + (which ? C_KD : C_QD) + lane * 8;
    const float* g = p.qk_norm_g + l * 128 + which * 64 + d0;
    u32x4 raw = *(const u32x4*)ptr;
    float x[8], y[8];
    UNPACK8(raw, x);
    float ss = 0.f;
#pragma unroll
    for (int e = 0; e < 8; ++e) ss += x[e] * x[e];
    ss = grp8_sum(ss);
    const float rstd = rsqrtf(ss * (1.f / 64.f) + 1e-6f);
    const float osc = which ? 1.f : 0.18033688011f;
#pragma unroll
    for (int e = 0; e < 8; ++e) y[e] = x[e] * rstd * g[e];
#pragma unroll
    for (int e = 0; e < 8; ++e) {
      float pv = dppf<0x4E>(y[e]);
      x[e] = (y[e] * cs[e] + sgn * pv * sn[e]) * osc;
    }
    *(u32x4*)ptr = PACK8(x);
  }
  u32x4 kkp;
  {
    u32x4 raw = *(const u32x4*)(pr + C_K + lane * 8);
    float x[8];
    UNPACK8(raw, x);
    const float* kkw = p.k_k + l * 512 + lane * 8;
    float ss = 0.f;
#pragma unroll
    for (int e = 0; e < 8; ++e) { x[e] *= kkw[e]; ss += x[e] * x[e]; }
    ss = grp8_sum(ss);
    const float rn = rsqrtf(ss + 1e-12f);
#pragma unroll
    for (int e = 0; e < 8; ++e) x[e] *= rn;
    kkp = PACK8(x);
  }
  {
    const int sp = lat ? t : s, sl = lat ? T : CTX;
    float gb[8], zb[8], g0[8], u0[8], gm[8], um[8], gp[8], up[8];
    u32x4 raw;
    raw = *(const u32x4*)(pr + C_GB + lane * 8); UNPACK8(raw, gb);
    raw = *(const u32x4*)(pr + C_ZB + lane * 8); UNPACK8(raw, zb);
    raw = *(const u32x4*)(pr + C_GC + lane * 8); UNPACK8(raw, g0);
    raw = *(const u32x4*)(pr + C_U + lane * 8); UNPACK8(raw, u0);
    if (sp > 0) {
      raw = *(const u32x4*)(pr - NP + C_GC + lane * 8); UNPACK8(raw, gm);
      raw = *(const u32x4*)(pr - NP + C_U + lane * 8); UNPACK8(raw, um);
    } else {
#pragma unroll
      for (int e = 0; e < 8; ++e) { gm[e] = 0.f; um[e] = 0.f; }
    }
    if (sp < sl - 1) {
      raw = *(const u32x4*)(pr + NP + C_GC + lane * 8); UNPACK8(raw, gp);
      raw = *(const u32x4*)(pr + NP + C_U + lane * 8); UNPACK8(raw, up);
    } else {
#pragma unroll
      for (int e = 0; e < 8; ++e) { gp[e] = 0.f; up[e] = 0.f; }
    }
    const float* cw = p.conv_w + l * 3 * 512 + lane * 8;
    const float* cb = p.conv_b + l * 512 + lane * 8;
    float y[8];
#pragma unroll
    for (int e = 0; e < 8; ++e) {
      float cv = cw[e] * gm[e] * um[e] + cw[512 + e] * g0[e] * u0[e] + cw[1024 + e] * gp[e] * up[e] + cb[e];
      y[e] = gb[e] * cv * siluf_(zb[e]);
    }
    *(u32x4*)(pr + C_YB + lane * 8) = PACK8(y);
  }
  *(u32x4*)(pr + C_KK + lane * 8) = kkp;
}
__device__ void phase_prep(const Params& p, int l, char* lds) {
  const int tid = opaque_tid(), lane = tid & 63, wid = tid >> 6;
  const int nspan = M / 136;
  for (int sp = blockIdx.x; sp < nspan; sp += gridDim.x) {
    const int row0 = sp * 136, b = row0 / S, s0 = row0 % S;
    for (int i = tid; i < 136 * 64; i += NTHR) {
      const int tok = i >> 6, ch = i & 63;
      *(u32x4*)(lds + tok * 1040 + ch * 16) = *(const u32x4*)(WS_PROJ(p) + (size_t)(row0 + tok) * NP + C_VD + ch * 8);
    }
    __syncthreads();
    for (int i = tid; i < 512 * 17; i += NTHR) {
      const int dv = i / 17, cch = i - dv * 17, head = dv >> 7, dvl = dv & 127;
      unsigned short e[8];
#pragma unroll
      for (int q = 0; q < 8; ++q) e[q] = *(const unsigned short*)(lds + (cch * 8 + q) * 1040 + dv * 2);
      u32x4 o = {(unsigned)e[0] | ((unsigned)e[1] << 16), (unsigned)e[2] | ((unsigned)e[3] << 16), (unsigned)e[4] | ((unsigned)e[5] << 16),
                 (unsigned)e[6] | ((unsigned)e[7] << 16)};
      *(u32x4*)(WS_VT(p) + ((size_t)(b * 4 + head) * 128 + dvl) * S + s0 + cch * 8) = o;
    }
    for (int i = 0; i < 17; ++i) prep_token(p, l, row0 + wid * 17 + i, lane);
    __syncthreads();
  }
}

constexpr int SC_CH = 32;
constexpr int SC_TS = 68, SC_VS = 36;
constexpr int SC_ARR = SC_CH * SC_TS * 4;
constexpr int SC_R = 0, SC_KK = SC_ARR, SC_W = 2 * SC_ARR, SC_KD = 3 * SC_ARR, SC_AK = 4 * SC_ARR, SC_V = 5 * SC_ARR, SC_BUF = 5 * SC_ARR + SC_CH * SC_VS * 4;
constexpr int SC_Y = 2 * SC_BUF;
constexpr int SC_WF = SC_Y + 8192;
__device__ __forceinline__ int scan_row(int b, int dir, int j) {
  const int s = dir == 0 ? j : (j < CTX ? (CTX - 1 - j) : (S + CTX - 1 - j));
  return b * S + s;
}
__device__ void phase_scan(const Params& p, int l, char* lds) {
  const int tid = opaque_tid(), lane = tid & 63, wid = tid >> 6, fr = lane & 15, fq = lane >> 4;
  for (int u = blockIdx.x; u < 256; u += gridDim.x) {
    const int pr_ = (u & 7) * 8 + (u >> 5), hd_ = (u >> 3) & 3;
    const int half = hd_ & 1, dir = hd_ >> 1, h = pr_ & 7, b = pr_ >> 3;
    const int c_lw = dir ? C_LWB : C_LWF, c_la = dir ? C_LAB : C_LAF, c_ys = dir ? C_YSB : C_YSF;
    if (wid == 4) {
      const float* du = p.decay_up + (size_t)(l * 2 + dir) * 64 * 512 + h * 64;
      const float* iu = p.iclr_up + (size_t)(l * 2 + dir) * 64 * 512 + h * 64;
#pragma unroll 1
      for (int f8 = 0; f8 < 8; ++f8) {
        const int nt = f8 >> 1, ks = f8 & 1;
        float fd[8], fi[8];
#pragma unroll
        for (int e = 0; e < 8; ++e) {
          const int k = ks * 32 + fq * 8 + e;
          fd[e] = du[(size_t)k * 512 + nt * 16 + fr];
          fi[e] = iu[(size_t)k * 512 + nt * 16 + fr];
        }
        *(u32x4*)(lds + SC_WF + (f8 * 64 + lane) * 16) = PACK8(fd);
        *(u32x4*)(lds + SC_WF + 8192 + (f8 * 64 + lane) * 16) = PACK8(fi);
      }
    }
    __syncthreads();
    const int pq = wid - 4, pth = pq & 1, pn0 = (pq >> 1) * 2, pti = pth * 16 + fr;
    bf16x8 P_tl[2], P_ta[2];
    u32x2 P_r[2], P_k[2], P_kk[2];
    u32x2 P_v;
    auto pload = [&](int c) {
      const bf16_t* pr = WS_PROJ(p) + (size_t)scan_row(b, dir, c * SC_CH + pti) * NP;
#pragma unroll
      for (int ks = 0; ks < 2; ++ks) {
        P_tl[ks] = *(const bf16x8*)(pr + c_lw + ks * 32 + fq * 8);
        P_ta[ks] = *(const bf16x8*)(pr + c_la + ks * 32 + fq * 8);
      }
#pragma unroll
      for (int n2 = 0; n2 < 2; ++n2) {
        const int gch = h * 64 + (pn0 + n2) * 16 + 4 * fq;
        P_r[n2] = *(const u32x2*)(pr + C_R + gch);
        P_k[n2] = *(const u32x2*)(pr + C_K + gch);
        P_kk[n2] = *(const u32x2*)(pr + C_KK + gch);
      }
      P_v = *(const u32x2*)(pr + C_V + h * 64 + half * 32 + (pq >> 1) * 16 + fq * 4);
    };
    f32x4 Cw0[2], Ca0[2], Cka[2];
    if (wid >= 4) {
#pragma unroll
      for (int n2 = 0; n2 < 2; ++n2) {
        const int gch = h * 64 + (pn0 + n2) * 16 + 4 * fq;
        Cw0[n2] = *(const f32x4*)(p.decay_w0 + (l * 2 + dir) * 512 + gch);
        Ca0[n2] = *(const f32x4*)(p.iclr_a0 + (l * 2 + dir) * 512 + gch);
        Cka[n2] = *(const f32x4*)(p.k_a + l * 512 + gch);
      }
    }
    auto pcompute = [&](int c) {
      char* buf = lds + (c & 1) * SC_BUF;
#pragma unroll
      for (int n2 = 0; n2 < 2; ++n2) {
        const int nt = pn0 + n2;
        f32x4 aw = {0.f, 0.f, 0.f, 0.f}, aa = {0.f, 0.f, 0.f, 0.f};
#pragma unroll
        for (int ks = 0; ks < 2; ++ks) {
          const bf16x8 wd = *(const bf16x8*)(lds + SC_WF + ((nt * 2 + ks) * 64 + lane) * 16);
          const bf16x8 wi = *(const bf16x8*)(lds + SC_WF + 8192 + ((nt * 2 + ks) * 64 + lane) * 16);
          aw = __builtin_amdgcn_mfma_f32_16x16x32_bf16(wd, P_tl[ks], aw, 0, 0, 0);
          aa = __builtin_amdgcn_mfma_f32_16x16x32_bf16(wi, P_ta[ks], aa, 0, 0, 0);
        }
        const int ch = nt * 16 + 4 * fq, gch = h * 64 + ch;
        const f32x4 w0 = Cw0[n2], a0 = Ca0[n2], ka = Cka[n2];
        const u32x2 r2 = P_r[n2], k2 = P_k[n2], kk2 = P_kk[n2];
        const f32x4 rv = {bf_lo(r2.x), bf_hi(r2.x), bf_lo(r2.y), bf_hi(r2.y)};
        const f32x4 kv = {bf_lo(k2.x), bf_hi(k2.x), bf_lo(k2.y), bf_hi(k2.y)};
        const f32x4 kkv = {bf_lo(kk2.x), bf_hi(kk2.x), bf_lo(kk2.y), bf_hi(kk2.y)};
        f32x4 wv, kd, ak;
#pragma unroll
        for (int j = 0; j < 4; ++j) {
          const float sg = sigmoidf_(aw[j] + w0[j]);
          wv[j] = __expf(-0.6065306597f * sg);
          const float a = sigmoidf_(aa[j] + a0[j]);
          kd[j] = kv[j] * (1.f + (a - 1.f) * ka[j]);
          ak[j] = a * kkv[j];
        }
        const int o = (pti * SC_TS + ch) * 4;
        *(f32x4*)(buf + SC_R + o) = rv;
        *(f32x4*)(buf + SC_KK + o) = kkv;
        *(f32x4*)(buf + SC_W + o) = wv;
        *(f32x4*)(buf + SC_KD + o) = kd;
        *(f32x4*)(buf + SC_AK + o) = ak;
      }
      *(f32x4*)(buf + SC_V + (pti * SC_VS + (pq >> 1) * 16 + fq * 4) * 4) = (f32x4){bf_lo(P_v.x), bf_hi(P_v.x), bf_lo(P_v.y), bf_hi(P_v.y)};
    };
    auto flush_y = [&](int c) {
      const int pt = tid - 256, tok = pt >> 3, r4 = (pt & 7) * 4;
      const f32x4 yv = *(const f32x4*)((const float*)(lds + SC_Y) + (c & 1) * 1024 + tok * 32 + r4);
      const int row = scan_row(b, dir, c * SC_CH + tok);
      const u32x2 o = {pack_bf16(yv.x, yv.y), pack_bf16(yv.z, yv.w)};
      *(u32x2*)(WS_PROJ(p) + (size_t)row * NP + c_ys + h * 64 + half * 32 + r4) = o;
    };
    const int nchunk = S / SC_CH;
    if (wid >= 4) { pload(0); pcompute(0); pload(1); }
    __syncthreads();
    f32x2 S2[4];
#pragma unroll
    for (int i = 0; i < 4; ++i) S2[i] = (f32x2){0.f, 0.f};
    const int rl = lane >> 3, cg8 = lane & 7;
    for (int c = 0; c < nchunk; ++c) {
      if (wid < 4) {
        const char* buf = lds + (c & 1) * SC_BUF;
        float* yb = (float*)(lds + SC_Y) + (c & 1) * 1024;
#define SC_LOAD(P, i_)                                                                                         \
  {                                                                                                            \
    const int o_ = ((i_) * SC_TS + cg8 * 8) * 4;                                                                  \
    P##ka = *(const f32x4*)(buf + SC_KK + o_); P##kb = *(const f32x4*)(buf + SC_KK + o_ + 16);                 \
    P##wa = *(const f32x4*)(buf + SC_W + o_);  P##wb = *(const f32x4*)(buf + SC_W + o_ + 16);                  \
    P##da = *(const f32x4*)(buf + SC_KD + o_); P##db = *(const f32x4*)(buf + SC_KD + o_ + 16);                 \
    P##aa = *(const f32x4*)(buf + SC_AK + o_); P##ab = *(const f32x4*)(buf + SC_AK + o_ + 16);                 \
    P##ra = *(const f32x4*)(buf + SC_R + o_);  P##rb = *(const f32x4*)(buf + SC_R + o_ + 16);                  \
    P##vv = *(const float*)(buf + SC_V + ((i_) * SC_VS + wid * 8 + rl) * 4);                                      \
  }
#define SC_STEP(P, i_)                                                                                         \
  {                                                                                                            \
    f32x2 d2 = S2[0] * (f32x2){P##ka.x, P##ka.y};                                                              \
    d2 = __builtin_elementwise_fma(S2[1], (f32x2){P##ka.z, P##ka.w}, d2);                                      \
    d2 = __builtin_elementwise_fma(S2[2], (f32x2){P##kb.x, P##kb.y}, d2);                                      \
    d2 = __builtin_elementwise_fma(S2[3], (f32x2){P##kb.z, P##kb.w}, d2);                                      \
      \
    float ra_ = d2.x + d2.y, rb_ = ypend;                                                                     \
    ra_ += dppf<0xB1>(ra_); rb_ += dppf<0xB1>(rb_);                                                            \
    ra_ += dppf<0x4E>(ra_); rb_ += dppf<0x4E>(rb_);                                                            \
    ra_ += dppf<0x141>(ra_); rb_ += dppf<0x141>(rb_);                                                          \
    yb[((i_) > 0 ? (i_) - 1 : 0) * 32 + wid * 8 + rl] = rb_;     \
    const float skk = ra_;                                                                                     \
    const f32x2 v2 = {P##vv, P##vv}, nk2 = {-skk, -skk};                                                       \
    f32x2 t0 = v2 * (f32x2){P##da.x, P##da.y}, t1 = v2 * (f32x2){P##da.z, P##da.w};                            \
    f32x2 t2 = v2 * (f32x2){P##db.x, P##db.y}, t3 = v2 * (f32x2){P##db.z, P##db.w};                            \
    t0 = __builtin_elementwise_fma(nk2, (f32x2){P##aa.x, P##aa.y}, t0);                                        \
    t1 = __builtin_elementwise_fma(nk2, (f32x2){P##aa.z, P##aa.w}, t1);                                        \
    t2 = __builtin_elementwise_fma(nk2, (f32x2){P##ab.x, P##ab.y}, t2);                                        \
    t3 = __builtin_elementwise_fma(nk2, (f32x2){P##ab.z, P##ab.w}, t3);                                        \
    S2[0] = __builtin_elementwise_fma(S2[0], (f32x2){P##wa.x, P##wa.y}, t0);                                   \
    S2[1] = __builtin_elementwise_fma(S2[1], (f32x2){P##wa.z, P##wa.w}, t1);                                   \
    S2[2] = __builtin_elementwise_fma(S2[2], (f32x2){P##wb.x, P##wb.y}, t2);                                   \
    S2[3] = __builtin_elementwise_fma(S2[3], (f32x2){P##wb.z, P##wb.w}, t3);                                   \
    f32x2 y2 = S2[0] * (f32x2){P##ra.x, P##ra.y};                                                              \
    y2 = __builtin_elementwise_fma(S2[1], (f32x2){P##ra.z, P##ra.w}, y2);                                      \
    y2 = __builtin_elementwise_fma(S2[2], (f32x2){P##rb.x, P##rb.y}, y2);                                      \
    y2 = __builtin_elementwise_fma(S2[3], (f32x2){P##rb.z, P##rb.w}, y2);                                      \
    ypend = y2.x + y2.y;                                         \
  }
        f32x4 Aka, Akb, Awa, Awb, Ada, Adb, Aaa, Aab, Ara, Arb, Bka, Bkb, Bwa, Bwb, Bda, Bdb, Baa, Bab, Bra, Brb;
        float Avv, Bvv, ypend = 0.f;
        SC_LOAD(A, 0);
#pragma unroll
        for (int i = 0; i < SC_CH; i += 2) {
          SC_LOAD(B, i + 1);
          SC_STEP(A, i);
          if (i + 2 < SC_CH) SC_LOAD(A, i + 2);
          SC_STEP(B, i + 1);
        }
        yb[(SC_CH - 1) * 32 + wid * 8 + rl] = allreduce8(ypend);
      } else {
        if (c + 1 < nchunk) pcompute(c + 1);
        if (c + 2 < nchunk) pload(c + 2);
        if (c > 0) flush_y(c - 1);
      }
      __syncthreads();
    }
    if (wid >= 4) flush_y(nchunk - 1);
    __syncthreads();
  }
}

constexpr int A_STAGE = 35840, A_VOFF = 17408, A_VSTR = 136;
__device__ void attn_unit(const Params& p, int l, int b, int head, int q0, int nkt, float lam, float lam_init, float bound2, char* lds) {
  int lane = __builtin_amdgcn_mbcnt_hi(~0u, __builtin_amdgcn_mbcnt_lo(~0u, 0u));
  asm volatile("" : "+v"(lane));
  const int wid = __builtin_amdgcn_readfirstlane(threadIdx.x >> 6), tid = wid * 64 + lane, fr = lane & 15, fq = lane >> 4;
  const int qrow = b * S + q0 + wid * 16 + fr;
  bf16x8 qf[2][2];
#pragma unroll
  for (int c = 0; c < 2; ++c)
#pragma unroll
    for (int ks = 0; ks < 2; ++ks) qf[c][ks] = *(const bf16x8*)(WS_PROJ(p) + (size_t)qrow * NP + C_QD + head * 128 + c * 64 + ks * 32 + fq * 8);
  f32x4 O[2][8];
  float ls[2] = {0.f, 0.f};
#pragma unroll
  for (int c = 0; c < 2; ++c)
#pragma unroll
    for (int dt = 0; dt < 8; ++dt) O[c][dt] = (f32x4){0.f, 0.f, 0.f, 0.f};
  const bf16_t* kg = WS_PROJ(p) + (size_t)(b * S + (tid >> 4)) * NP + C_KD + head * 128 + (tid & 15) * 8;
  const bf16_t* vg = WS_VT(p) + ((size_t)(b * 4 + head) * 128 + (tid >> 3)) * S + (tid & 7) * 8;
  const int ksto = (tid >> 4) * 272 + (tid & 15) * 16, vsto = A_VOFF + (tid >> 3) * A_VSTR + (tid & 7) * 16;
  u32x4 rk[2], rv[2];
#pragma unroll
  for (int i = 0; i < 2; ++i) {
    rk[i] = *(const u32x4*)(kg + (size_t)(32 * i) * NP);
    rv[i] = *(const u32x4*)(vg + (size_t)(64 * i) * S);
  }
#pragma unroll
  for (int i = 0; i < 2; ++i) {
    *(u32x4*)(lds + ksto + i * 32 * 272) = rk[i];
    *(u32x2*)(lds + vsto + i * 64 * A_VSTR) = (u32x2){rv[i].x, rv[i].y};
    *(u32x2*)(lds + vsto + i * 64 * A_VSTR + 8) = (u32x2){rv[i].z, rv[i].w};
  }
  __syncthreads();
  for (int kt = 0; kt < nkt; ++kt) {
    const char* base = lds + (kt & 1) * A_STAGE;
    const bool more = kt + 1 < nkt;
    if (more) {
#pragma unroll
      for (int i = 0; i < 2; ++i) {
        rk[i] = *(const u32x4*)(kg + (size_t)((kt + 1) * 64 + 32 * i) * NP);
        rv[i] = *(const u32x4*)(vg + (size_t)(64 * i) * S + (kt + 1) * 64);
      }
    }
#pragma unroll
    for (int g = 0; g < 2; ++g) {
      bf16x8 pf[2];
#pragma unroll
      for (int c = 0; c < 2; ++c) {
        f32x4 sa[2];
        sa[0] = (f32x4){-bound2, -bound2, -bound2, -bound2};
        sa[1] = sa[0];
#pragma unroll
        for (int ks = 0; ks < 2; ++ks)
#pragma unroll
          for (int k2 = 0; k2 < 2; ++k2) {
            const bf16x8 kf = *(const bf16x8*)(base + ((g * 2 + k2) * 16 + fr) * 272 + (c * 64 + ks * 32 + fq * 8) * 2);
            sa[k2] = __builtin_amdgcn_mfma_f32_16x16x32_bf16(kf, qf[c][ks], sa[k2], 0, 0, 0);
          }
        float acc_l = 0.f;
#pragma unroll
        for (int k2 = 0; k2 < 2; ++k2)
#pragma unroll
          for (int j = 0; j < 4; ++j) {
            const float pe = __builtin_amdgcn_exp2f(sa[k2][j]);
            sa[k2][j] = pe;
            acc_l += pe;
          }
        ls[c] += acc_l;
        u32x4 pk = {pack_bf16_b(sa[0][0], sa[0][1]), pack_bf16_b(sa[0][2], sa[0][3]), pack_bf16_b(sa[1][0], sa[1][1]), pack_bf16_b(sa[1][2], sa[1][3])};
        pf[c] = __builtin_bit_cast(bf16x8, pk);
      }
#pragma unroll
      for (int dt = 0; dt < 8; ++dt) {
        const u32x2 v0 = *(const u32x2*)(base + A_VOFF + (dt * 16 + fr) * A_VSTR + (g * 32 + 4 * fq) * 2);
        const u32x2 v1 = *(const u32x2*)(base + A_VOFF + (dt * 16 + fr) * A_VSTR + (g * 32 + 16 + 4 * fq) * 2);
        const u32x4 vv = {v0.x, v0.y, v1.x, v1.y};
        const bf16x8 vf = __builtin_bit_cast(bf16x8, vv);
        O[0][dt] = __builtin_amdgcn_mfma_f32_16x16x32_bf16(vf, pf[0], O[0][dt], 0, 0, 0);
        O[1][dt] = __builtin_amdgcn_mfma_f32_16x16x32_bf16(vf, pf[1], O[1][dt], 0, 0, 0);
      }
    }
    if (more) {
      char* nb = lds + ((kt + 1) & 1) * A_STAGE;
#pragma unroll
      for (int i = 0; i < 2; ++i) {
        *(u32x4*)(nb + ksto + i * 32 * 272) = rk[i];
        *(u32x2*)(nb + vsto + i * 64 * A_VSTR) = (u32x2){rv[i].x, rv[i].y};
        *(u32x2*)(nb + vsto + i * 64 * A_VSTR + 8) = (u32x2){rv[i].z, rv[i].w};
      }
    }
    __syncthreads();
  }
  float l0 = ls[0], l1 = ls[1];
  l0 += shflx(l0, 16, lane); l0 += shflx(l0, 32, lane);
  l1 += shflx(l1, 16, lane); l1 += shflx(l1, 32, lane);
  const float i0 = 1.f / l0, i1 = lam / l1;
  float ss = 0.f;
#pragma unroll
  for (int dt = 0; dt < 8; ++dt) {
    f32x4 o = O[0][dt] * i0 - O[1][dt] * i1;
    O[0][dt] = o;
    ss += o.x * o.x + o.y * o.y + o.z * o.z + o.w * o.w;
  }
  ss += shflx(ss, 16, lane); ss += shflx(ss, 32, lane);
  const float rn = rsqrtf(ss * (1.f / 128.f) + 1e-6f) * (1.f - lam_init);
  bf16_t* pr = WS_PROJ(p) + (size_t)qrow * NP + head * 128 + 4 * fq;
  const float* sg = p.subln_g + l * 128 + 4 * fq;
#pragma unroll
  for (int dt = 0; dt < 8; ++dt) {
    const int dv = dt * 16;
    const u32x2 z2 = *(const u32x2*)(pr + C_ZC + dv);
    const f32x4 g4 = *(const f32x4*)(sg + dv);
    const f32x4 o = O[0][dt];
    const float y0 = o.x * rn * g4.x * siluf_(bf_lo(z2.x)), y1 = o.y * rn * g4.y * siluf_(bf_hi(z2.x));
    const float y2 = o.z * rn * g4.z * siluf_(bf_lo(z2.y)), y3 = o.w * rn * g4.w * siluf_(bf_hi(z2.y));
    u32x2 ov = {pack_bf16(y0, y1), pack_bf16(y2, y3)};
    *(u32x2*)(pr + C_YC + dv) = ov;
  }
}
__device__ __forceinline__ void rwkv_out_token(const Params& p, int l, int row, int lane) {
  bf16_t* pr = WS_PROJ(p) + (size_t)row * NP;
  float yf[8], yb[8], r[8], k[8], v[8], z[8];
  u32x4 raw;
  raw = *(const u32x4*)(pr + C_YSF + lane * 8); UNPACK8(raw, yf);
  raw = *(const u32x4*)(pr + C_YSB + lane * 8); UNPACK8(raw, yb);
  raw = *(const u32x4*)(pr + C_R + lane * 8); UNPACK8(raw, r);
  raw = *(const u32x4*)(pr + C_K + lane * 8); UNPACK8(raw, k);
  raw = *(const u32x4*)(pr + C_V + lane * 8); UNPACK8(raw, v);
  raw = *(const u32x4*)(pr + C_ZA + lane * 8); UNPACK8(raw, z);
  const float* rk = p.r_k + l * 512 + lane * 8;
  const float* gg = p.gn_g + l * 512 + lane * 8;
  const float* gb = p.gn_b + l * 512 + lane * 8;
  float sm = 0.f, bs = 0.f;
#pragma unroll
  for (int e = 0; e < 8; ++e) { yf[e] += yb[e]; sm += yf[e]; bs += r[e] * k[e] * rk[e]; }
  sm = grp8_sum(sm); bs = grp8_sum(bs);
  const float mu = sm * (1.f / 64.f);
  float vs = 0.f;
#pragma unroll
  for (int e = 0; e < 8; ++e) { yf[e] -= mu; vs += yf[e] * yf[e]; }
  vs = grp8_sum(vs);
  const float rs = rsqrtf(vs * (1.f / 64.f) + 64e-5f);
  float o[8];
#pragma unroll
  for (int e = 0; e < 8; ++e) o[e] = (yf[e] * rs * gg[e] + gb[e] + bs * v[e]) * siluf_(z[e]);
  *(u32x4*)(pr + C_YA + lane * 8) = PACK8(o);
}
__device__ void phase_attn(const Params& p, int l, char* lds) {
  const int tid0 = opaque_tid();
  const int lane = tid0 & 63;
  const float lam_init = __int_as_float(__builtin_amdgcn_readfirstlane(__float_as_int(0.8f - 0.6f * __expf(-0.3f * (float)l))));
  const float* lq = p.lambda_qk + l * 256;
  float a1 = lq[lane] * lq[64 + lane], a2 = lq[128 + lane] * lq[192 + lane];
  a1 = wave_sum(a1); a2 = wave_sum(a2);
  const float lam = __int_as_float(__builtin_amdgcn_readfirstlane(__float_as_int(__expf(a1) - __expf(a2) + lam_init)));
  const float* qg = p.qk_norm_g + l * 128;
  float mq = fabsf(qg[lane]), mk = fabsf(qg[64 + lane]);
  mq = wave_max(mq); mk = wave_max(mk);
  const float bound2 = __int_as_float(__builtin_amdgcn_readfirstlane(__float_as_int(8.f * mq * mk * 1.44269504f * 1.02f + 0.1f)));
  const int nunit = (l < NL - 1) ? 1088 : 1024;
  for (int u = blockIdx.x; u < nunit; u += gridDim.x) {
    int b, head, q0, nkt;
    if (u < 1024) {
      const int xcd = u & 7, j = u >> 3, pair = xcd + 8 * (j >> 5), qb = j & 31;
      head = pair & 3; b = pair >> 2; q0 = CTX + qb * 128; nkt = S / 64;
    } else {
      const int v = u - 1024; head = (v >> 1) & 3; b = v >> 3; q0 = (v & 1) * 128; nkt = CTX / 64;
    }
    attn_unit(p, l, b, head, q0, nkt, lam, lam_init, bound2, lds);
  }
  const int tid1 = opaque_tid();
  const int gw = blockIdx.x * 8 + (tid1 >> 6), nw = gridDim.x * 8;
  for (int row = gw; row < M; row += nw) rwkv_out_token(p, l, row, tid1 & 63);
}

__device__ void phase_merge1(const Params& p, int l, char* lds) {
  const int tid = opaque_tid(), lane = tid & 63, wid = tid >> 6, wm = wid >> 1, wn = wid & 1, fr = lane & 15, fq = lane >> 4;
  const int xcd = blockIdx.x & 7, bi = blockIdx.x >> 3, nbx = (gridDim.x + 7 - xcd) >> 3;
  for (int idx = bi; idx < 17 * 8; idx += nbx) {
    const int mt = 17 * xcd + (idx >> 3), nt = idx & 7;
    if (l == NL - 1 && (mt % 17) == 0) continue;
    u32x2 macc[4][4];
#pragma unroll
    for (int mi = 0; mi < 4; ++mi)
#pragma unroll
      for (int ni = 0; ni < 4; ++ni) macc[mi][ni] = (u32x2){0u, 0u};
#pragma unroll 1
    for (int i = 0; i < 3; ++i) {
      const int ycol = i == 0 ? C_YA : (i == 1 ? C_YB : C_YC);
      f32x4 acc[4][4];
#pragma unroll
      for (int mi = 0; mi < 4; ++mi)
#pragma unroll
        for (int ni = 0; ni < 4; ++ni) acc[mi][ni] = (f32x4){0.f, 0.f, 0.f, 0.f};
      gemm_256x128_dma(WS_PROJ(p) + (size_t)mt * 256 * NP + ycol, NP, WS_WB(p) + (size_t)(l & 1) * WSET + ((size_t)i * D + nt * 128) * 512, 512, 512, acc, lds, tid);
      u32x2 br[4][4];
#pragma unroll
      for (int mi = 0; mi < 4; ++mi)
#pragma unroll
        for (int ni = 0; ni < 4; ++ni) {
          const f32x4 av = mfma_guard(acc[mi][ni]);
          br[mi][ni] = (u32x2){pack_bf16(av.x, av.y), pack_bf16(av.z, av.w)};
          acc[mi][ni] = (f32x4){0.f, 0.f, 0.f, 0.f};
        }
      gemm_256x128_dma(WS_H(p) + (size_t)mt * 256 * D, D, WS_WG(p) + (size_t)(l & 1) * WSET + ((size_t)i * D + nt * 128) * D, D, D, acc, lds, tid);
#pragma unroll
      for (int mi = 0; mi < 4; ++mi)
#pragma unroll
        for (int ni = 0; ni < 4; ++ni) {
          const f32x4 a = acc[mi][ni];
          const u32x2 bb = br[mi][ni], mm = macc[mi][ni];
          const float m0 = bf_lo(mm.x) + sigmoidf_(a.x) * bf_lo(bb.x), m1 = bf_hi(mm.x) + sigmoidf_(a.y) * bf_hi(bb.x);
          const float m2 = bf_lo(mm.y) + sigmoidf_(a.z) * bf_lo(bb.y), m3 = bf_hi(mm.y) + sigmoidf_(a.w) * bf_hi(bb.y);
          macc[mi][ni] = (u32x2){pack_bf16(m0, m1), pack_bf16(m2, m3)};
        }
    }
#pragma unroll
    for (int mi = 0; mi < 4; ++mi) {
      const int row = mt * 256 + wm * 64 + mi * 16 + fr;
#pragma unroll
      for (int ni = 0; ni < 4; ++ni) {
        const int col = nt * 128 + wn * 64 + ni * 16 + 4 * fq;
        *(u32x2*)(WS_PROJ(p) + (size_t)row * NP + ((nt < 4) ? C_M0 : (C_M1 - 512)) + col) = macc[mi][ni];
      }
    }
  }
}

__device__ void phase_merge2(const Params& p, int l, char* lds) {
  const int tid = opaque_tid(), lane = tid & 63, wid = tid >> 6, wm = wid >> 1, wn = wid & 1, fr = lane & 15, fq = lane >> 4;
  const int xcd = blockIdx.x & 7, bi = blockIdx.x >> 3, nbx = (gridDim.x + 7 - xcd) >> 3;
  for (int idx = bi; idx < 17 * 8; idx += nbx) {
    const int mt = 17 * xcd + (idx >> 3), nt = idx & 7;
    const bool isctx = (mt % 17) == 0;
    if (l == NL - 1 && isctx) continue;
    f32x4 acc[4][4];
#pragma unroll
    for (int mi = 0; mi < 4; ++mi)
#pragma unroll
      for (int ni = 0; ni < 4; ++ni) acc[mi][ni] = (f32x4){0.f, 0.f, 0.f, 0.f};
    gemm_256x128_dma(WS_PROJ(p) + (size_t)mt * 256 * NP + C_M0, NP, WS_WO(p) + (size_t)(l & 1) * WSET + (size_t)nt * 128 * D, D, D, acc, lds, tid, 8,
                     (C_M1 - C_M0 - 512) * 2);
    const int b = mt / 17;
    const float* gate = WS_MOD(p) + ((size_t)l * 9 + (isctx ? 8 : b)) * 3072 + 2048;
#pragma unroll
    for (int mi = 0; mi < 4; ++mi) {
      const int row = mt * 256 + wm * 64 + mi * 16 + fr, s = row - b * S;
      const float* xs = xrow_src(p, l, b, s);
      float* xd = isctx ? (WS_CTXS(p) + ((size_t)b * CTX + s) * D) : (p.out + ((size_t)b * T + (s - CTX)) * D);
#pragma unroll
      for (int ni = 0; ni < 4; ++ni) {
        const int col = nt * 128 + wn * 64 + ni * 16 + 4 * fq;
        const f32x4 g = *(const f32x4*)(gate + col);
        const f32x4 xv = *(const f32x4*)(xs + col);
        *(f32x4*)(xd + col) = xv + g * acc[mi][ni];
      }
    }
  }
}

#ifndef MULTI_LAUNCH
#define MULTI_LAUNCH 0
#endif
#ifndef DUMP_STAGE
#define DUMP_STAGE 0
#define NL_RUN 4
#define PROBE_MEMSET 1
#endif
#if !MULTI_LAUNCH && !DUMP_STAGE
__device__ __forceinline__ void l2_refresh(const Params& p, unsigned seq) {
  const float* base = (seq & 1u) ? p.x : p.w_in;
  const f32x4* src = (const f32x4*)(base + (size_t)blockIdx.x * 131072) + threadIdx.x;
  f32x4 a = {0.f, 0.f, 0.f, 0.f};
#pragma unroll 4
  for (int i = 0; i < 64; ++i) a += src[i * NTHR];
  asm volatile("" ::"v"(a.x), "v"(a.y), "v"(a.z), "v"(a.w));
}

__device__ __forceinline__ void grid_barrier(unsigned* bar, unsigned target) {
  asm volatile("s_waitcnt vmcnt(0) lgkmcnt(0)" ::: "memory");
  __syncthreads();
  if (threadIdx.x == 0) {
    __builtin_amdgcn_fence(__ATOMIC_RELEASE, "");
    asm volatile("s_waitcnt vmcnt(0)" ::: "memory");
    __hip_atomic_fetch_add(bar, 1u, __ATOMIC_RELAXED, __HIP_MEMORY_SCOPE_AGENT);
    while ((int)(__hip_atomic_load(bar, __ATOMIC_RELAXED, __HIP_MEMORY_SCOPE_AGENT) - target) < 0) __builtin_amdgcn_s_sleep(2);
    __builtin_amdgcn_fence(__ATOMIC_ACQUIRE, "");
    asm volatile("s_waitcnt vmcnt(0)" ::: "memory");
  }
  __syncthreads();
}

__device__ void phase_dump(const Params& p, int what) {
  const size_t n = (size_t)NB * T * D;
  for (size_t i = blockIdx.x * (size_t)NTHR + threadIdx.x; i < n; i += (size_t)gridDim.x * NTHR) {
    float v = 0.f;
    if (what == 1) { const int rr = (int)(i / D) % S; v = bf_lo(WS_H(p)[i]); (void)rr; }
    else if (what == 7) v = bf_lo(WS_WG(p)[i % ((size_t)3072 * D)]) + bf_lo(WS_WB(p)[i % ((size_t)1536 * D)]) + bf_lo(WS_WO(p)[i % ((size_t)D * D)]);
    else if (what == 6) { const unsigned* q = (const unsigned*)(WS_PROJ(p) + i * 6);
      for (int j = 0; j < 3; ++j) { unsigned w = __hip_atomic_load(q + j, __ATOMIC_RELAXED, __HIP_MEMORY_SCOPE_AGENT); v += bf_lo(w) + bf_hi(w); } }
    else { for (int j = 0; j < 6; ++j) v += bf_lo(WS_PROJ(p)[i * 6 + j]); if (what == 3) v += bf_lo(WS_VT(p)[i % ((size_t)NB * 4 * 128 * S)]); }
    p.out[i] = v;
  }
}
#ifndef PROBE_TWICE
#define PROBE_TWICE 0
#endif
#ifndef MK_DUMP
#define MK_DUMP 0
#define MK_DUMP_L 0
#endif
__global__ void __launch_bounds__(NTHR) fwd_megakernel(Params p, int l0, int l1) {
  __shared__ __attribute__((aligned(16))) char lds[LDS_BYTES];
  cg::grid_group grid = cg::this_grid();
  unsigned nbar = __builtin_amdgcn_readfirstlane(__hip_atomic_load(WS_BAR(p), __ATOMIC_RELAXED, __HIP_MEMORY_SCOPE_AGENT));
  grid.sync();
  const unsigned nblk = gridDim.x;
#define NL_MK 2
  unsigned nflush = 0;
#define GSYNC() do { nbar += nblk; grid_barrier(WS_BAR(p), nbar); } while (0)
#define GSYNC_REFRESH() do { nbar += nblk; grid_barrier(WS_BAR(p), nbar); l2_refresh(p, nflush++); nbar += nblk; grid_barrier(WS_BAR(p), nbar); } while (0)
  if (l0 == 0) { phase_mod(p, lds); GSYNC(); }
  for (int l = l0; l < l1; ++l) {
    if (MK_DUMP == 8 && l == MK_DUMP_L) return;
    phase_norm(p, l);
    if (l == l0) phase_cvt(p, l, lds, blockIdx.x, gridDim.x);
    GSYNC();
    if (MK_DUMP == 1 && l == MK_DUMP_L) { phase_dump(p, 1); return; }
    if (MK_DUMP == 7 && l == MK_DUMP_L) { phase_dump(p, 7); return; }
    phase_inproj(p, l, lds);
#if PROBE_TWICE == 1
    GSYNC(); phase_inproj(p, l, lds);
#endif
    GSYNC();
    if (MK_DUMP == 2 && l == MK_DUMP_L) { phase_dump(p, 2); return; }
    phase_prep(p, l, lds);
    GSYNC();
    if (MK_DUMP == 3 && l == MK_DUMP_L) { phase_dump(p, 3); return; }
    phase_scan(p, l, lds);
#if PROBE_TWICE == 2
    GSYNC(); phase_scan(p, l, lds);
#endif
    GSYNC_REFRESH();
    if (MK_DUMP == 4 && l == MK_DUMP_L) { phase_dump(p, 4); return; }
    phase_attn(p, l, lds);
    GSYNC();
    if (MK_DUMP == 5 && l == MK_DUMP_L) { phase_dump(p, 5); return; }
    phase_merge1(p, l, lds);
#if PROBE_TWICE == 3
    GSYNC(); phase_merge1(p, l, lds);
#endif
    GSYNC();
    if (MK_DUMP == 6 && l == MK_DUMP_L) { phase_dump(p, 6); return; }
    phase_merge2(p, l, lds);
    if (l + 1 < l1) {
      if (gridDim.x == 256) { const int bi = blockIdx.x >> 3; if (bi >= 8) phase_cvt(p, l + 1, lds, (bi - 8) * 8 + (blockIdx.x & 7), 192); }
      else phase_cvt(p, l + 1, lds, blockIdx.x, gridDim.x);
    }
    if (l + 1 < l1) GSYNC_REFRESH();
  }
}
#endif
#if MULTI_LAUNCH || DUMP_STAGE
__global__ void __launch_bounds__(NTHR) phase_kernel(Params p, int phase, int l) {
  __shared__ __attribute__((aligned(16))) char lds[LDS_BYTES];
  switch (phase) {
    case 0: phase_mod(p, lds); break;
    case 1: phase_norm(p, l); phase_cvt(p, l, lds, blockIdx.x, gridDim.x); break;
    case 2: phase_inproj(p, l, lds); break;
    case 3: phase_prep(p, l, lds); break;
    case 4: phase_scan(p, l, lds); break;
    case 5: phase_attn(p, l, lds); break;
    case 6: phase_merge1(p, l, lds); break;
    default: phase_merge2(p, l, lds); break;
  }
}

__global__ void dump_kernel(Params p, int stage, int n) {
  for (size_t i = blockIdx.x * (size_t)blockDim.x + threadIdx.x; i < (size_t)n; i += (size_t)gridDim.x * blockDim.x) {
    float v = 0.f;
    if (stage == 1) v = WS_MOD(p)[i % (NL * 9 * 3072)];
    else if (stage == 2) v = bf_lo(WS_H(p)[i]);
    else if (stage == 3) v = bf_lo(WS_WIN(p)[i % ((size_t)NP * D)]) + bf_lo(WS_WG(p)[i % ((size_t)3072 * D)]) + bf_lo(WS_WB(p)[i % ((size_t)1536 * D)]) + bf_lo(WS_WO(p)[i % ((size_t)D * D)]);
    else if (stage == 4 || stage == 5) { for (int j = 0; j < 6; ++j) v += bf_lo(WS_PROJ(p)[i * 6 + j]); if (stage == 5) v += bf_lo(WS_VT(p)[i % ((size_t)NB * 4 * 128 * S)]); }
    p.out[i] = v;
  }
}
#endif

extern "C" void kernel_launch(void* const* d_in, const int* in_sizes, int n_in, void* d_out, int out_size, void* d_ws, size_t ws_size,
                              hipStream_t stream) {
  static int grid_blocks = 0;
#if !MULTI_LAUNCH && !DUMP_STAGE
  if (!grid_blocks) {
    int dev = 0, cus = 0, per_cu = 0;
    hipGetDevice(&dev);
    hipDeviceGetAttribute(&cus, hipDeviceAttributeMultiprocessorCount, dev);
    hipOccupancyMaxActiveBlocksPerMultiprocessor(&per_cu, fwd_megakernel, NTHR, 0);
    if (per_cu < 1) per_cu = 1;
    grid_blocks = cus * per_cu;
  }
#endif
  Params p{};
  const float** f = (const float**)&p;
  for (int i = 0; i < 24; ++i) f[i] = (const float*)d_in[i];
  p.out = (float*)d_out;
  p.ws = (char*)d_ws;
  const size_t off = WS_TOTAL;
  if (off > ws_size) { fprintf(stderr, "workspace too small: need %zu have %zu\n", off, ws_size); return; }
  hipMemsetAsync(WS_BAR(p), 0, 256, stream);
#if DUMP_STAGE
  {
    const int maxph = DUMP_STAGE == 1 ? 0 : (DUMP_STAGE <= 3 ? 1 : (DUMP_STAGE == 4 ? 2 : 3));
    for (int ph = 0; ph <= maxph; ++ph) phase_kernel<<<dim3(256), dim3(NTHR), 0, stream>>>(p, ph, 0);
    dump_kernel<<<dim3(1024), dim3(256), 0, stream>>>(p, DUMP_STAGE, out_size);
    return;
  }
#endif
#if MULTI_LAUNCH
  phase_kernel<<<dim3(256), dim3(NTHR), 0, stream>>>(p, 0, 0);
  for (int l = 0; l < NL_RUN; ++l)
    for (int ph = 1; ph <= 7; ++ph) {
#ifdef SKIP_SCAN
      if (ph == 4) continue;
#endif
#ifdef SKIP_ATTN
      if (ph == 5) continue;
#endif
      phase_kernel<<<dim3(256), dim3(NTHR), 0, stream>>>(p, ph, l);
    }
  return;
#endif
#if !MULTI_LAUNCH && !DUMP_STAGE
#ifndef LAYERS_PER_LAUNCH
#define LAYERS_PER_LAUNCH 4
#endif
  for (int l0 = 0; l0 < (MK_DUMP ? MK_DUMP_L + 1 : NL); l0 += LAYERS_PER_LAUNCH) {
    int a0 = l0, a1 = l0 + LAYERS_PER_LAUNCH;
    void* args[] = {&p, &a0, &a1};
    hipError_t e = hipLaunchCooperativeKernel((void*)fwd_megakernel, dim3(grid_blocks), dim3(NTHR), args, 0, stream);
    if (e != hipSuccess) fprintf(stderr, "cooperative launch failed: %s (grid %d)\n", hipGetErrorString(e), grid_blocks);
  }
#endif
}
```
